# Optimizing an MI355X kernel written in HIP

```python
import jax, jax.numpy as jnp
from jax import lax
import numpy as np

D_MODEL = 1024
BATCH = 2
SEQ = 16384
DEPTH = 4

CONV_WIDTH = 512
CONV_K = 3
SWA_HEADS = 8
SWA_KV_HEADS = 2
SWA_HEAD_DIM = 64
WINDOW = 128
SWA_BLOCK = 128
GLA_HEADS = 4
GLA_DK = 64
GLA_DV = 128
GLA_GATE_RANK = 16
GLA_GATE_TAU = 16.0
GLA_CHUNK = 64
MLA_HEADS = 4
MLA_Q_RANK = 256
MLA_KV_RANK = 128
MLA_NOPE = 64
MLA_ROPE = 32
MLA_V = 128
MLA_BLOCK = 128
ROPE_THETA = 10000.0
D_FF = ((-(-8 * D_MODEL // 3) + 255) // 256) * 256
ALPHA = (2.0 * DEPTH) ** 0.25
BETA = (8.0 * DEPTH) ** -0.25
LN_EPS = 1e-5
RMS_EPS = 1e-6

N_EVEN = (DEPTH + 1) // 2
N_ODD = DEPTH // 2

EVEN_SPLITS = [CONV_WIDTH, CONV_WIDTH, CONV_WIDTH,
               SWA_HEADS * SWA_HEAD_DIM, SWA_KV_HEADS * SWA_HEAD_DIM, SWA_KV_HEADS * SWA_HEAD_DIM]
EVEN_IN = sum(EVEN_SPLITS)
EVEN_MIX = CONV_WIDTH + SWA_HEADS * SWA_HEAD_DIM
ODD_SPLITS = [GLA_HEADS * GLA_DK, GLA_HEADS * GLA_DK, GLA_HEADS * GLA_DV, GLA_GATE_RANK,
              GLA_HEADS * GLA_DV, MLA_Q_RANK, MLA_KV_RANK, MLA_ROPE]
ODD_IN = sum(ODD_SPLITS)
ODD_MIX = GLA_HEADS * GLA_DV + MLA_HEADS * MLA_V

kernel_name = "hybrid_conv_swa_gla_mla_deepnorm"


def split_cols(u, sizes):
    return jnp.split(u, np.cumsum(sizes)[:-1].tolist(), axis=-1)


def layer_norm(x, g, b):
    xf = x.astype(jnp.float32)
    mu = xf.mean(-1, keepdims=True)
    var = jnp.mean(jnp.square(xf - mu), -1, keepdims=True)
    return ((xf - mu) * lax.rsqrt(var + LN_EPS) * g.astype(jnp.float32) + b.astype(jnp.float32)).astype(x.dtype)


def rms_norm(x, g):
    xf = x.astype(jnp.float32)
    ms = jnp.mean(jnp.square(xf), -1, keepdims=True)
    return (xf * lax.rsqrt(ms + RMS_EPS) * g.astype(jnp.float32)).astype(x.dtype)


def apply_rope(t, cos, sin):
    t1, t2 = jnp.split(t, 2, axis=-1)
    return jnp.concatenate([t1 * cos - t2 * sin, t2 * cos + t1 * sin], axis=-1)


def short_conv_mixer(b_gate, c_gate, h, conv_w):
    S = h.shape[1]
    z = c_gate * h
    zp = jnp.pad(z, ((0, 0), (CONV_K - 1, 0), (0, 0)))
    y = zp[:, 0:S] * conv_w[0]
    for j in range(1, CONV_K):
        y = y + zp[:, j:j + S] * conv_w[j]
    return b_gate * y


def swa_sink_attention(q, k, v, sinks):
    B_, S, _ = q.shape
    nb = S // SWA_BLOCK
    G = SWA_HEADS // SWA_KV_HEADS
    q = q.reshape(B_, nb, SWA_BLOCK, SWA_KV_HEADS, G, SWA_HEAD_DIM)
    k = k.reshape(B_, nb, SWA_BLOCK, SWA_KV_HEADS, SWA_HEAD_DIM)
    v = v.reshape(B_, nb, SWA_BLOCK, SWA_KV_HEADS, SWA_HEAD_DIM)
    pad = ((0, 0), (1, 0), (0, 0), (0, 0), (0, 0))
    kk = jnp.concatenate([jnp.pad(k, pad)[:, :-1], k], axis=2)
    vv = jnp.concatenate([jnp.pad(v, pad)[:, :-1], v], axis=2)
    s = jnp.einsum('bnqhgd,bnkhd->bnhgqk', q, kk).astype(jnp.float32) * (SWA_HEAD_DIM ** -0.5)
    qi = jnp.arange(SWA_BLOCK)[:, None]
    kj = jnp.arange(2 * SWA_BLOCK)[None, :] - SWA_BLOCK
    diff = qi - kj
    band = (diff >= 0) & (diff < WINDOW)
    valid = (jnp.arange(nb)[:, None, None] > 0) | (kj[None] >= 0)
    mask = band[None] & valid
    s = jnp.where(mask[None, :, None, None], s, -jnp.inf)
    sink = sinks.astype(jnp.float32).reshape(SWA_KV_HEADS, G)[None, None, :, :, None, None]
    m = jnp.maximum(s.max(-1, keepdims=True), sink)
    p = jnp.exp(s - m)
    p = p / (p.sum(-1, keepdims=True) + jnp.exp(sink - m))
    o = jnp.einsum('bnhgqk,bnkhd->bnqhgd', p.astype(v.dtype), vv)
    return o.reshape(B_, S, SWA_HEADS * SWA_HEAD_DIM)


def gla_mixer(q, k, v, g_low, r, w_gate, b_gate, g_norm):
    B_, S, _ = q.shape
    H, C = GLA_HEADS, GLA_CHUNK
    nc = S // C
    log_a = jax.nn.log_sigmoid((g_low @ w_gate + b_gate).astype(jnp.float32)) / GLA_GATE_TAU

    def to_chunks(t, d):
        return t.astype(jnp.float32).reshape(B_, nc, C, H, d).transpose(1, 0, 3, 2, 4)

    qc = to_chunks(q, GLA_DK) * (GLA_DK ** -0.5)
    kc = to_chunks(k, GLA_DK)
    vc = to_chunks(v, GLA_DV)
    gc = to_chunks(log_a, GLA_DK)
    causal = jnp.tril(jnp.ones((C, C), bool))[:, :, None]

    def step(state, inp):
        qb, kb, vb, gb = inp
        b = jnp.cumsum(gb, axis=2)
        o_inter = jnp.einsum('bhtd,bhdv->bhtv', qb * jnp.exp(b), state)
        diff = b[:, :, :, None, :] - b[:, :, None, :, :]
        decay = jnp.exp(jnp.where(causal, diff, -jnp.inf))
        attn = jnp.einsum('bhtd,bhsd,bhtsd->bhts', qb, kb, decay)
        o = o_inter + jnp.einsum('bhts,bhsv->bhtv', attn, vb)
        b_last = b[:, :, -1:, :]
        k_dec = kb * jnp.exp(b_last - b)
        state = jnp.exp(b_last[:, :, 0, :])[..., None] * state + jnp.einsum('bhsd,bhsv->bhdv', k_dec, vb)
        return state, o

    s0 = jnp.zeros((B_, H, GLA_DK, GLA_DV), jnp.float32)
    _, o = lax.scan(step, s0, (qc, kc, vc, gc))
    o = o.transpose(1, 0, 3, 2, 4).reshape(B_, S, H, GLA_DV)
    o = rms_norm(o, g_norm).reshape(B_, S, H * GLA_DV)
    return (o * jax.nn.silu(r.astype(jnp.float32))).astype(q.dtype)


def mla_mixer(c_q, c_kv, k_r, g_qn, w_uq, g_kvn, w_ukv, cos, sin):
    B_, S, _ = c_q.shape
    H = MLA_HEADS
    q = (rms_norm(c_q, g_qn) @ w_uq).reshape(B_, S, H, MLA_NOPE + MLA_ROPE)
    q_nope = q[..., :MLA_NOPE]
    q_rope = apply_rope(q[..., MLA_NOPE:], cos[:, None, :], sin[:, None, :])
    kv = (rms_norm(c_kv, g_kvn) @ w_ukv).reshape(B_, S, H, MLA_NOPE + MLA_V)
    k_nope, v = kv[..., :MLA_NOPE], kv[..., MLA_NOPE:]
    k_rope = apply_rope(k_r, cos, sin)
    scale = (MLA_NOPE + MLA_ROPE) ** -0.5
    nb = S // MLA_BLOCK
    qn_b = q_nope.reshape(B_, nb, MLA_BLOCK, H, MLA_NOPE).transpose(1, 0, 2, 3, 4)
    qr_b = q_rope.reshape(B_, nb, MLA_BLOCK, H, MLA_ROPE).transpose(1, 0, 2, 3, 4)
    kpos = jnp.arange(S)

    def attend(args):
        qn, qr, i = args
        s = (jnp.einsum('bqhd,bkhd->bhqk', qn, k_nope) +
             jnp.einsum('bqhr,bkr->bhqk', qr, k_rope)).astype(jnp.float32) * scale
        qpos = i * MLA_BLOCK + jnp.arange(MLA_BLOCK)
        s = jnp.where(kpos[None, :] <= qpos[:, None], s, -jnp.inf)
        p = jax.nn.softmax(s, axis=-1)
        return jnp.einsum('bhqk,bkhv->bqhv', p.astype(v.dtype), v)

    o = lax.map(attend, (qn_b, qr_b, jnp.arange(nb)))
    return o.transpose(1, 0, 2, 3, 4).reshape(B_, S, H * MLA_V)


def swiglu(x, w_gate, w_up, w_down):
    return (jax.nn.silu(x @ w_gate) * (x @ w_up)) @ w_down


def setup_inputs(seed: int = 0) -> dict:
    key = jax.random.key(seed)
    ks = iter(jax.random.split(key, 32))
    nrm = lambda shape, s: jax.random.normal(next(ks), shape, jnp.float32) * s
    D = D_MODEL
    return {
        "x": nrm((BATCH, SEQ, D), 1.0),
        "ev_w_in": nrm((N_EVEN, D, EVEN_IN), D ** -0.5),
        "ev_conv_w": nrm((N_EVEN, CONV_K, CONV_WIDTH), CONV_K ** -0.5),
        "ev_sinks": nrm((N_EVEN, SWA_HEADS), 0.5),
        "ev_w_out": nrm((N_EVEN, EVEN_MIX, D), BETA * EVEN_MIX ** -0.5),
        "od_w_in": nrm((N_ODD, D, ODD_IN), D ** -0.5),
        "od_gla_w_gate": nrm((N_ODD, GLA_GATE_RANK, GLA_HEADS * GLA_DK), GLA_GATE_RANK ** -0.5),
        "od_gla_b_gate": nrm((N_ODD, GLA_HEADS * GLA_DK), 0.1),
        "od_gla_norm_g": 1.0 + nrm((N_ODD, GLA_DV), 0.02),
        "od_mla_q_norm_g": 1.0 + nrm((N_ODD, MLA_Q_RANK), 0.02),
        "od_mla_w_uq": nrm((N_ODD, MLA_Q_RANK, MLA_HEADS * (MLA_NOPE + MLA_ROPE)), MLA_Q_RANK ** -0.5),
        "od_mla_kv_norm_g": 1.0 + nrm((N_ODD, MLA_KV_RANK), 0.02),
        "od_mla_w_ukv": nrm((N_ODD, MLA_KV_RANK, MLA_HEADS * (MLA_NOPE + MLA_V)), MLA_KV_RANK ** -0.5),
        "od_w_out": nrm((N_ODD, ODD_MIX, D), BETA * ODD_MIX ** -0.5),
        "ffn_w_gate": nrm((DEPTH, D, D_FF), D ** -0.5),
        "ffn_w_up": nrm((DEPTH, D, D_FF), D ** -0.5),
        "ffn_w_down": nrm((DEPTH, D_FF, D), BETA * D_FF ** -0.5),
        "ln_mix_g": 1.0 + nrm((DEPTH, D), 0.02),
        "ln_mix_b": nrm((DEPTH, D), 0.02),
        "ln_ffn_g": 1.0 + nrm((DEPTH, D), 0.02),
        "ln_ffn_b": nrm((DEPTH, D), 0.02),
    }


def reference(x, ev_w_in, ev_conv_w, ev_sinks, ev_w_out, od_w_in, od_gla_w_gate, od_gla_b_gate,
              od_gla_norm_g, od_mla_q_norm_g, od_mla_w_uq, od_mla_kv_norm_g, od_mla_w_ukv, od_w_out,
              ffn_w_gate, ffn_w_up, ffn_w_down, ln_mix_g, ln_mix_b, ln_ffn_g, ln_ffn_b):
    S = x.shape[1]
    pos = jnp.arange(S, dtype=jnp.float32)
    inv_freq = ROPE_THETA ** (-jnp.arange(0, MLA_ROPE, 2, dtype=jnp.float32) / MLA_ROPE)
    ang = pos[:, None] * inv_freq[None, :]
    cos, sin = jnp.cos(ang).astype(x.dtype), jnp.sin(ang).astype(x.dtype)

    for layer in range(DEPTH):
        i = layer // 2
        if layer % 2 == 0:
            u = x @ ev_w_in[i]
            b_g, c_g, h, q, k, v = split_cols(u, EVEN_SPLITS)
            ya = short_conv_mixer(b_g, c_g, h, ev_conv_w[i])
            yb = swa_sink_attention(q, k, v, ev_sinks[i])
            y = jnp.concatenate([ya, yb], axis=-1) @ ev_w_out[i]
        else:
            u = x @ od_w_in[i]
            gq, gk, gv, g_low, gr, c_q, c_kv, k_r = split_cols(u, ODD_SPLITS)
            yc = gla_mixer(gq, gk, gv, g_low, gr, od_gla_w_gate[i], od_gla_b_gate[i], od_gla_norm_g[i])
            yd = mla_mixer(c_q, c_kv, k_r, od_mla_q_norm_g[i], od_mla_w_uq[i],
                           od_mla_kv_norm_g[i], od_mla_w_ukv[i], cos, sin)
            y = jnp.concatenate([yc, yd], axis=-1) @ od_w_out[i]
        x = layer_norm(ALPHA * x + y, ln_mix_g[layer], ln_mix_b[layer])
        x = layer_norm(ALPHA * x + swiglu(x, ffn_w_gate[layer], ffn_w_up[layer], ffn_w_down[layer]),
                       ln_ffn_g[layer], ln_ffn_b[layer])
    return x
```

```cpp
#include <hip/hip_runtime.h>
#include <hip/hip_cooperative_groups.h>
#include <cstdio>
#include <cstdint>
namespace cg = cooperative_groups;

#ifndef ONE_LAUNCH
#define ONE_LAUNCH 1
#endif

#ifndef REP
#define REP 0
#endif
#define LAS __attribute__((address_space(3)))
#define DI __device__ __forceinline__
typedef unsigned short bf16_t;
typedef short bf16x8 __attribute__((ext_vector_type(8)));
typedef short s16x4 __attribute__((ext_vector_type(4)));
typedef float f32x4 __attribute__((ext_vector_type(4)));
typedef float f32x16 __attribute__((ext_vector_type(16)));
typedef unsigned u32x4 __attribute__((ext_vector_type(4)));
typedef unsigned u32x2 __attribute__((ext_vector_type(2)));

__device__ __forceinline__ int opq_tid() { int t = threadIdx.x; asm volatile("" : "+v"(t)); return t; }
__device__ __forceinline__ int opq_bid() { int t = blockIdx.x; asm volatile("" : "+s"(t)); return t; }
namespace pg8 {
#define PG8_LAS __attribute__((address_space(3)))
constexpr int BM = 256, BK = 64, HALF = 128, HTB = HALF * BK * 2, STAGE_BYTES = 8 * HTB, NXCD = 8, WGM = 8;

__host__ __device__ __forceinline__ int lds_byte(int r, int c) { const int st = (r >> 4) * 2 + (c >> 5), rr = r & 15, cc = c & 31, ob = rr * 64 + cc * 2; return st * 1024 + (ob ^ (((ob >> 9) & 1) << 5)); }
__host__ __device__ __forceinline__ void stage_rc(int b, int& R, int& C) { const int st = b / 1024, sb = b % 1024, swz = sb ^ (((sb >> 9) & 1) << 5); R = (st >> 1) * 16 + swz / 64; C = (st & 1) * 32 + (swz % 64) / 2; }
__host__ __device__ __forceinline__ int perm32(int rho) { const int n = rho >> 4, i = rho & 15; return 8 * (i >> 2) + 4 * n + (i & 3); }

struct Unit { int pm, pn; };
struct Gemm { const bf16_t* A; const bf16_t* Bt; int M, N, K; };

struct StaticOrder {
    int nM, nN, nwg, G, c;
    __host__ __device__ void init(int M, int N, int G_, int c_) { nM = M / BM; nN = N / BM; nwg = nM * nN; G = G_; c = c_; }
    __host__ __device__ bool next(int i, Unit& u) const {
        const long L = (long)i * G + c; if (L >= nwg) return false;
        int wgid = (int)L; { const int q = nwg / NXCD, r = nwg % NXCD, xcd = wgid % NXCD, off = wgid / NXCD; wgid = (xcd < r ? xcd * (q + 1) : r * (q + 1) + (xcd - r) * q) + off; }
        const int nig = WGM * nN, gid = wgid / nig, fm = gid * WGM, gsz = (nM - fm) < WGM ? (nM - fm) : WGM;
        u.pm = fm + ((wgid % nig) % gsz); u.pn = (wgid % nig) / gsz; return true;
    }
    __device__ __forceinline__ void a_ready(const Unit&) const {}
    __device__ __forceinline__ void done(const Unit&) const {}
};

__device__ __forceinline__ unsigned cvt_pk_bf16(float lo, float hi) { unsigned r; asm volatile("v_cvt_pk_bf16_f32 %0, %1, %2" : "=v"(r) : "v"(lo), "v"(hi)); return r; }

constexpr int XSLOT_OFF = STAGE_BYTES, XSLOT_BYTES = 10240, RED_OFF = XSLOT_OFF + 2 * XSLOT_BYTES;
struct LnFold { const float* st; const float* c1; const float* c2; int on; };
__device__ __forceinline__ void xslot_fetch(const float* st_rows, const float* v1, const float* v2, PG8_LAS unsigned char* slot, int tid, int wid) {
    __builtin_amdgcn_global_load_lds((const unsigned*)(st_rows + tid * 4), (PG8_LAS unsigned*)(slot + wid * 1024), 16, 0, 0);
    const float* vp = wid < 4 ? v1 + tid : v2 + (tid - 256);
    __builtin_amdgcn_global_load_lds((const unsigned*)vp, (PG8_LAS unsigned*)(slot + 8192 + wid * 256), 4, 0, 0);
}
__device__ __forceinline__ void ln_rows8(bool on, const PG8_LAS float* X, int rl0, float (&mean)[8], float (&rstd)[8]) {
#pragma unroll
    for (int i = 0; i < 8; ++i) { const int rl = rl0 + (i >> 2) * HALF + (i & 3) * 16; const f32x4 a = *(const PG8_LAS f32x4*)(X + 8 * rl), b = *(const PG8_LAS f32x4*)(X + 8 * rl + 4);
        const float s1 = on ? (a[0] + a[2]) + (b[0] + b[2]) : 0.f, s2 = on ? (a[1] + a[3]) + (b[1] + b[3]) : 1024.f;
        mean[i] = s1 * (1.f / 1024.f); const float var = s2 * (1.f / 1024.f) - mean[i] * mean[i]; rstd[i] = on ? __builtin_amdgcn_rsqf(fmaxf(var, 0.f) + 1e-5f) : 1.f; }
}
__device__ __forceinline__ void ln_row1(bool on, const PG8_LAS float* X, int rl, float& mean, float& rstd) {
    const f32x4 a = *(const PG8_LAS f32x4*)(X + 8 * rl), b = *(const PG8_LAS f32x4*)(X + 8 * rl + 4);
    const float s1 = on ? (a[0] + a[2]) + (b[0] + b[2]) : 0.f, s2 = on ? (a[1] + a[3]) + (b[1] + b[3]) : 1024.f;
    mean = s1 * (1.f / 1024.f); const float var = s2 * (1.f / 1024.f) - mean * mean; rstd = on ? __builtin_amdgcn_rsqf(fmaxf(var, 0.f) + 1e-5f) : 1.f;
}
struct NoPre {};
struct EpiBf16 {
    static constexpr bool PERM = true, AFTER_DRAIN = false;
    typedef NoPre Pre; __device__ __forceinline__ void preload(Pre&, const Unit&, int, int, int, int) const {}
    bf16_t* O; int ldc; LnFold f;
    __device__ __forceinline__ void prefetch(const Unit& u, PG8_LAS unsigned char* slot, int tid, int wid) const { if (f.on) xslot_fetch(f.st + 8 * (u.pm * BM), f.c1 + u.pn * BM, f.c2 + u.pn * BM, slot, tid, wid); }
    __device__ __forceinline__ void operator()(const f32x4 (&acc)[2][2][4][2], const Unit& u, int wr, int wc, int fr, int fq, const PG8_LAS float* X, PG8_LAS float* RED, const Pre&) const {
        const int row0 = u.pm * BM + wr * 64 + fr; const int cl0 = wc * 32 + 8 * fq, col0 = u.pn * BM + cl0; const bool on = f.on != 0;
        f32x4 c1v[2][2], c2v[2][2];
#pragma unroll
        for (int bj = 0; bj < 2; ++bj)
#pragma unroll
            for (int n = 0; n < 2; ++n) { const f32x4 a = *(const PG8_LAS f32x4*)(X + 2048 + cl0 + bj * HALF + 4 * n), b = *(const PG8_LAS f32x4*)(X + 2304 + cl0 + bj * HALF + 4 * n);
                c1v[bj][n] = on ? a : (f32x4){0.f, 0.f, 0.f, 0.f}; c2v[bj][n] = on ? b : (f32x4){0.f, 0.f, 0.f, 0.f}; }
        float mean8[8], rstd8[8]; ln_rows8(on, X, wr * 64 + fr, mean8, rstd8);
#pragma unroll
        for (int ai = 0; ai < 2; ++ai)
#pragma unroll
            for (int m = 0; m < 4; ++m) { const int row = row0 + ai * HALF + m * 16; bf16_t* rowp = O + (size_t)row * ldc + col0;
                const float mean = mean8[ai * 4 + m], rstd = rstd8[ai * 4 + m];
#pragma unroll
                for (int bj = 0; bj < 2; ++bj) { const f32x4 v0 = (acc[ai][bj][m][0] - c1v[bj][0] * mean) * rstd + c2v[bj][0], v1 = (acc[ai][bj][m][1] - c1v[bj][1] * mean) * rstd + c2v[bj][1];
                    u32x4 w; w.x = cvt_pk_bf16(v0[0], v0[1]); w.y = cvt_pk_bf16(v0[2], v0[3]); w.z = cvt_pk_bf16(v1[0], v1[1]); w.w = cvt_pk_bf16(v1[2], v1[3]);
                    *(u32x4*)(rowp + bj * HALF) = w; } }
    }
};
__device__ __forceinline__ float silu_f(float x) { return x * __builtin_amdgcn_rcpf(1.f + __builtin_amdgcn_exp2f(-x * 1.4426950408889634f)); }
struct EpiSwiglu {
    static constexpr bool PERM = true, AFTER_DRAIN = false;
    typedef NoPre Pre; __device__ __forceinline__ void preload(Pre&, const Unit&, int, int, int, int) const {}
    bf16_t* H; int ldc; LnFold f;
    __device__ __forceinline__ void prefetch(const Unit& u, PG8_LAS unsigned char* slot, int tid, int wid) const { xslot_fetch(f.st + 8 * (u.pm * BM), f.c1 + u.pn * BM, f.c2 + u.pn * BM, slot, tid, wid); }
    __device__ __forceinline__ void operator()(const f32x4 (&acc)[2][2][4][2], const Unit& u, int wr, int wc, int fr, int fq, const PG8_LAS float* X, PG8_LAS float* RED, const Pre&) const {
        const int row0 = u.pm * BM + wr * 64 + fr; const int cl0 = wc * 32 + 8 * fq, col0 = u.pn * HALF + cl0;
        f32x4 c1v[2][2], c2v[2][2];
#pragma unroll
        for (int bj = 0; bj < 2; ++bj)
#pragma unroll
            for (int n = 0; n < 2; ++n) { c1v[bj][n] = *(const PG8_LAS f32x4*)(X + 2048 + cl0 + bj * HALF + 4 * n); c2v[bj][n] = *(const PG8_LAS f32x4*)(X + 2304 + cl0 + bj * HALF + 4 * n); }
        float mean8[8], rstd8[8]; ln_rows8(true, X, wr * 64 + fr, mean8, rstd8);
#pragma unroll
        for (int ai = 0; ai < 2; ++ai)
#pragma unroll
            for (int m = 0; m < 4; ++m) { const int row = row0 + ai * HALF + m * 16; bf16_t* rowp = H + (size_t)row * ldc + col0;
                const float mean = mean8[ai * 4 + m], rstd = rstd8[ai * 4 + m];
                const f32x4 g0 = (acc[ai][0][m][0] - c1v[0][0] * mean) * rstd + c2v[0][0], g1 = (acc[ai][0][m][1] - c1v[0][1] * mean) * rstd + c2v[0][1];
                const f32x4 u0 = (acc[ai][1][m][0] - c1v[1][0] * mean) * rstd + c2v[1][0], u1 = (acc[ai][1][m][1] - c1v[1][1] * mean) * rstd + c2v[1][1];
                u32x4 w; w.x = cvt_pk_bf16(silu_f(g0[0]) * u0[0], silu_f(g0[1]) * u0[1]); w.y = cvt_pk_bf16(silu_f(g0[2]) * u0[2], silu_f(g0[3]) * u0[3]);
                w.z = cvt_pk_bf16(silu_f(g1[0]) * u1[0], silu_f(g1[1]) * u1[1]); w.w = cvt_pk_bf16(silu_f(g1[2]) * u1[2], silu_f(g1[3]) * u1[3]);
                *(u32x4*)rowp = w; }
    }
};
struct EpiRes {
    static constexpr bool PERM = true, AFTER_DRAIN = false;
    const float* xin; float* zf; bf16_t* zb; const float* st_prev; const float* gp; const float* bp; float* st_out; int ldc; float alpha;
    __device__ __forceinline__ void prefetch(const Unit& u, PG8_LAS unsigned char* slot, int tid, int wid) const { if (st_prev) xslot_fetch(st_prev + 8 * (u.pm * BM), gp + u.pn * BM, bp + u.pn * BM, slot, tid, wid); }
    struct Pre { u32x4 a, b; };
    __device__ __forceinline__ void preload(Pre& p, const Unit& u, int wr, int wc, int fr, int fq) const {
        if (!xin) { asm volatile("" : "+v"(fr), "+v"(fq)); const size_t o = (size_t)(u.pm * BM + wr * 64 + fr) * ldc + u.pn * BM + wc * 32 + 8 * fq; p.a = *(const u32x4*)(zb + o); p.b = *(const u32x4*)(zb + o + HALF); }
    }
    static __device__ __forceinline__ void unpack8(const u32x4 w, f32x4& lo, f32x4& hi) {
        lo[0] = __builtin_bit_cast(float, w.x << 16); lo[1] = __builtin_bit_cast(float, w.x & 0xffff0000u); lo[2] = __builtin_bit_cast(float, w.y << 16); lo[3] = __builtin_bit_cast(float, w.y & 0xffff0000u);
        hi[0] = __builtin_bit_cast(float, w.z << 16); hi[1] = __builtin_bit_cast(float, w.z & 0xffff0000u); hi[2] = __builtin_bit_cast(float, w.w << 16); hi[3] = __builtin_bit_cast(float, w.w & 0xffff0000u);
    }
    __device__ __forceinline__ void ldres8(size_t o, f32x4& lo, f32x4& hi) const {
        if (xin) { lo = *(const f32x4*)(xin + o); hi = *(const f32x4*)(xin + o + 4); return; }
        const u32x4 w = *(const u32x4*)(zb + o);
        lo[0] = __builtin_bit_cast(float, w.x << 16); lo[1] = __builtin_bit_cast(float, w.x & 0xffff0000u); lo[2] = __builtin_bit_cast(float, w.y << 16); lo[3] = __builtin_bit_cast(float, w.y & 0xffff0000u);
        hi[0] = __builtin_bit_cast(float, w.z << 16); hi[1] = __builtin_bit_cast(float, w.z & 0xffff0000u); hi[2] = __builtin_bit_cast(float, w.w << 16); hi[3] = __builtin_bit_cast(float, w.w & 0xffff0000u);
    }
    __device__ __forceinline__ void operator()(const f32x4 (&acc)[2][2][4][2], const Unit& u, int wr, int wc, int fr, int fq, const PG8_LAS float* X, PG8_LAS float* RED, const Pre& pre) const {
        typedef float f32x2v __attribute__((ext_vector_type(2)));
        asm volatile("" : "+v"(fr), "+v"(fq));
        const int rl0 = wr * 64 + fr, row0 = u.pm * BM + rl0; const int cl0 = wc * 32 + 8 * fq, col0 = u.pn * BM + cl0; const bool on = st_prev != nullptr;
        u32x4 rw[2];
        if (!xin) { rw[0] = pre.a; rw[1] = pre.b; }
#pragma unroll
        for (int i = 0; i < 8; ++i) { const int ai = i >> 2, m = i & 3; const int rl = rl0 + ai * HALF + m * 16; const size_t off = (size_t)(u.pm * BM + rl) * ldc + col0;
            f32x4 r[2][2];
            if (xin) {
#pragma unroll
                for (int bj = 0; bj < 2; ++bj) { r[bj][0] = *(const f32x4*)(xin + off + bj * HALF); r[bj][1] = *(const f32x4*)(xin + off + bj * HALF + 4); }
            } else {
#pragma unroll
                for (int bj = 0; bj < 2; ++bj) unpack8(rw[bj], r[bj][0], r[bj][1]);
                if (i < 7) { const size_t offn = (size_t)(row0 + ((i + 1) >> 2) * HALF + ((i + 1) & 3) * 16) * ldc + col0;
#pragma unroll
                    for (int bj = 0; bj < 2; ++bj) rw[bj] = *(const u32x4*)(zb + offn + bj * HALF); } }
            float mean, rstd; ln_row1(on, X, rl, mean, rstd);
            float s1 = 0.f, s2 = 0.f;
#pragma unroll
            for (int bj = 0; bj < 2; ++bj) { f32x4 z[2];
#pragma unroll
                for (int n = 0; n < 2; ++n) { const int cq = bj * HALF + 4 * n;
                    const f32x4 ga = *(const PG8_LAS f32x4*)(X + 2048 + cl0 + cq), ba = *(const PG8_LAS f32x4*)(X + 2304 + cl0 + cq);
                    const f32x4 x = on ? (r[bj][n] - mean) * rstd * ga + ba : r[bj][n];
                    z[n] = x * alpha + acc[ai][bj][m][n];
                    s1 += (z[n][0] + z[n][1]) + (z[n][2] + z[n][3]); s2 += (z[n][0] * z[n][0] + z[n][1] * z[n][1]) + (z[n][2] * z[n][2] + z[n][3] * z[n][3]); }
                const size_t o = off + bj * HALF;
                if (zf) { *(f32x4*)(zf + o) = z[0]; *(f32x4*)(zf + o + 4) = z[1]; }
                u32x4 w; w.x = cvt_pk_bf16(z[0][0], z[0][1]); w.y = cvt_pk_bf16(z[0][2], z[0][3]); w.z = cvt_pk_bf16(z[1][0], z[1][1]); w.w = cvt_pk_bf16(z[1][2], z[1][3]); if (!zf) *(u32x4*)(zb + o) = w; }
            s1 += __shfl_xor(s1, 16); s1 += __shfl_xor(s1, 32); s2 += __shfl_xor(s2, 16); s2 += __shfl_xor(s2, 32);
            if (fq == 0) *(PG8_LAS f32x2v*)(RED + (rl * 4 + wc) * 2) = (f32x2v){s1, s2};
            __builtin_amdgcn_sched_barrier(0); }
        asm volatile("s_waitcnt lgkmcnt(0)" ::: "memory"); __builtin_amdgcn_s_barrier(); asm volatile("" ::: "memory");
        { const int t = (wr * 4 + wc) * 64 + fq * 16 + fr;
          if (t < BM) { const f32x4 a = *(const PG8_LAS f32x4*)(RED + t * 8), b = *(const PG8_LAS f32x4*)(RED + t * 8 + 4);
              *(f32x2v*)(st_out + ((size_t)(u.pm * BM + t) * 4 + u.pn) * 2) = (f32x2v){(a[0] + a[2]) + (b[0] + b[2]), (a[1] + a[3]) + (b[1] + b[3])}; } }
    }
};

template <class Epi, class Sched, bool ALIGN_EPI = false, bool SP2 = false>
__device__ __forceinline__ void gemm_phase(PG8_LAS unsigned char* lds, const Gemm g, const Sched& S, const Epi& E) {
    const int tid = opq_tid(), wid = __builtin_amdgcn_readfirstlane(tid >> 6), lane = tid & 63, wr = wid >> 2, wc = wid & 3, fr = lane & 15, fq = lane >> 4;
    const int K = g.K, nt = K / BK;
    unsigned voffA[2], voffB[2];
#pragma unroll
    for (int i = 0; i < 2; ++i) { int R, C; stage_rc(tid * 16 + i * 8192, R, C); const int Rb = Epi::PERM ? ((R & ~31) + perm32(R & 31)) : R;
        voffA[i] = (unsigned)(R * K + C) * 2u; voffB[i] = (unsigned)(Rb * K + C) * 2u; }
    const size_t kstep = (size_t)(BK * 2);
    const size_t hstep = (size_t)HALF * K * 2;
    const size_t tstep = 2 * hstep;
    const unsigned ldsw = (unsigned)wid * 1024u;
    const int aoff = lds_byte(wr * 64 + fr, fq * 8), boff = lds_byte(wc * 32 + fr, fq * 8);
#define PG8_SA(b, h) (((b) * 2 + (h)) * HTB)
#define PG8_SB(b, h) ((4 + (b) * 2 + (h)) * HTB)
#define PG8_STAGE(bufoff, gbase, voff) do { _Pragma("unroll") for (int _i = 0; _i < 2; ++_i) \
        __builtin_amdgcn_global_load_lds((const unsigned*)((const char*)(gbase) + (voff)[_i]), (PG8_LAS unsigned*)(lds + (bufoff) + ldsw + _i * 8192), 16, 0, 0); } while (0)
#define PG8_LDA(dst, b, h) do { _Pragma("unroll") for (int m = 0; m < 4; ++m) _Pragma("unroll") for (int k = 0; k < 2; ++k) dst[m][k] = *(const PG8_LAS bf16x8*)(lds + PG8_SA(b, h) + aoff + m * 2048 + k * 1024); } while (0)
#define PG8_LDB(dst, b, h) do { _Pragma("unroll") for (int n = 0; n < 2; ++n) _Pragma("unroll") for (int k = 0; k < 2; ++k) dst[n][k] = *(const PG8_LAS bf16x8*)(lds + PG8_SB(b, h) + boff + n * 2048 + k * 1024); } while (0)
#define PG8_MMA(ai, bj, At, Bt) do { __builtin_amdgcn_s_setprio(1); _Pragma("unroll") for (int m = 0; m < 4; ++m) _Pragma("unroll") for (int n = 0; n < 2; ++n) _Pragma("unroll") for (int k = 0; k < 2; ++k) \
        acc[ai][bj][m][n] = __builtin_amdgcn_mfma_f32_16x16x32_bf16(Bt[n][k], At[m][k], acc[ai][bj][m][n], 0, 0, 0); __builtin_amdgcn_s_setprio(0); } while (0)
#define PG8_WAIT_V(n) asm volatile("s_waitcnt vmcnt(" #n ")" ::: "memory")
#define PG8_WAIT_L(n) asm volatile("s_waitcnt lgkmcnt(" #n ")" ::: "memory")
#define PG8_BAR __builtin_amdgcn_s_barrier()
#define PG8_SCHED __builtin_amdgcn_sched_barrier(0)
    Unit cur, nxt; int ui = 0;
    if (!S.next(0, cur)) return;
    f32x4 acc[2][2][4][2];
#pragma unroll
    for (int a = 0; a < 2; ++a)
#pragma unroll
        for (int b = 0; b < 2; ++b)
#pragma unroll
            for (int m = 0; m < 4; ++m)
#pragma unroll
                for (int n = 0; n < 2; ++n) acc[a][b][m][n] = (f32x4){0.f, 0.f, 0.f, 0.f};
    bf16x8 At[4][2], B0[2][2], B1[2][2];
    typename Epi::Pre pre;
    const char* cA = (const char*)g.A + (size_t)cur.pm * tstep; const char* cB = (const char*)g.Bt + (size_t)cur.pn * tstep;
    S.a_ready(cur);
    E.prefetch(cur, lds + XSLOT_OFF, tid, wid);
    if constexpr (SP2) {
        PG8_STAGE(PG8_SB(0, 0), cB, voffB); PG8_STAGE(PG8_SB(0, 1), cB + hstep, voffB); PG8_STAGE(PG8_SA(0, 0), cA, voffA); PG8_STAGE(PG8_SA(0, 1), cA + hstep, voffA);
        if (wr == 1) PG8_BAR;
        PG8_WAIT_V(2); PG8_BAR;
        PG8_STAGE(PG8_SB(1, 0), cB + kstep, voffB); PG8_STAGE(PG8_SA(1, 0), cA + kstep, voffA); PG8_STAGE(PG8_SB(1, 1), cB + hstep + kstep, voffB);
        PG8_WAIT_V(6); PG8_BAR;
    } else {
        PG8_STAGE(PG8_SB(0, 0), cB, voffB); PG8_STAGE(PG8_SA(0, 0), cA, voffA); PG8_STAGE(PG8_SB(0, 1), cB + hstep, voffB); PG8_STAGE(PG8_SA(0, 1), cA + hstep, voffA);
        if (wr == 1) PG8_BAR;
        PG8_WAIT_V(4); PG8_BAR;
        PG8_STAGE(PG8_SB(1, 0), cB + kstep, voffB); PG8_STAGE(PG8_SA(1, 0), cA + kstep, voffA); PG8_STAGE(PG8_SB(1, 1), cB + hstep + kstep, voffB);
        PG8_WAIT_V(6); PG8_BAR;
    }
    for (;;) {
        const bool has_next = S.next(ui + 1, nxt);
        const char* nA = has_next ? (const char*)g.A + (size_t)nxt.pm * tstep : cA; const char* nB = has_next ? (const char*)g.Bt + (size_t)nxt.pn * tstep : cB;
        for (int t = 0; t < nt; t += 2) {
            const bool last = (t == nt - 2);
            const char* a1 = cA + (size_t)(t + 1) * kstep;
            const char* a2 = last ? nA : cA + (size_t)(t + 2) * kstep; const char* b2 = last ? nB : cB + (size_t)(t + 2) * kstep;
            const char* a3 = a2 + kstep; const char* b3 = b2 + kstep;
            if (last) E.preload(pre, cur, wr, wc, fr, fq);
            if (last && has_next) { S.a_ready(nxt); E.prefetch(nxt, lds + XSLOT_OFF + ((ui + 1) & 1) * XSLOT_BYTES, tid, wid); }
            if constexpr (SP2) {
            PG8_LDB(B0, 0, 0); PG8_LDB(B1, 0, 1); PG8_SCHED; PG8_LDA(At, 0, 0); PG8_STAGE(PG8_SA(1, 1), a1 + hstep, voffA);
            PG8_WAIT_V(8); PG8_WAIT_L(0); PG8_BAR; PG8_MMA(0, 0, At, B0); PG8_MMA(0, 1, At, B1); PG8_BAR; PG8_SCHED;
            PG8_LDA(At, 0, 1); PG8_STAGE(PG8_SB(0, 0), b2, voffB); PG8_STAGE(PG8_SB(0, 1), b2 + hstep, voffB); PG8_STAGE(PG8_SA(0, 0), a2, voffA);
            PG8_WAIT_V(8); PG8_WAIT_L(0); PG8_BAR; PG8_MMA(1, 0, At, B0); PG8_MMA(1, 1, At, B1); PG8_BAR; PG8_SCHED;
            PG8_LDB(B0, 1, 0); PG8_LDB(B1, 1, 1); PG8_SCHED; PG8_LDA(At, 1, 0); PG8_STAGE(PG8_SA(0, 1), a2 + hstep, voffA);
            PG8_WAIT_V(8); PG8_WAIT_L(0); PG8_BAR; PG8_MMA(0, 0, At, B0); PG8_MMA(0, 1, At, B1); PG8_BAR; PG8_SCHED;
            PG8_LDA(At, 1, 1); PG8_STAGE(PG8_SB(1, 0), b3, voffB); PG8_STAGE(PG8_SB(1, 1), b3 + hstep, voffB); PG8_STAGE(PG8_SA(1, 0), a3, voffA);
            PG8_WAIT_V(8); PG8_WAIT_L(0); PG8_BAR; PG8_MMA(1, 0, At, B0); PG8_MMA(1, 1, At, B1); PG8_BAR; PG8_SCHED;
            } else {
            PG8_LDB(B0, 0, 0); PG8_SCHED; PG8_LDA(At, 0, 0); PG8_STAGE(PG8_SA(1, 1), a1 + hstep, voffA);
            PG8_WAIT_L(8); PG8_BAR; PG8_WAIT_L(0); PG8_MMA(0, 0, At, B0); PG8_BAR; PG8_SCHED;
            PG8_LDB(B1, 0, 1); PG8_STAGE(PG8_SB(0, 0), b2, voffB);
            PG8_BAR; PG8_WAIT_L(0); PG8_MMA(0, 1, At, B1); PG8_BAR;
            PG8_LDA(At, 0, 1); PG8_STAGE(PG8_SA(0, 0), a2, voffA);
            PG8_BAR; PG8_WAIT_L(0); PG8_MMA(1, 0, At, B0); PG8_BAR; PG8_SCHED;
            PG8_STAGE(PG8_SB(0, 1), b2 + hstep, voffB);
            PG8_WAIT_V(6); PG8_BAR; PG8_MMA(1, 1, At, B1); PG8_BAR;
            PG8_LDB(B0, 1, 0); PG8_SCHED; PG8_LDA(At, 1, 0); PG8_STAGE(PG8_SA(0, 1), a2 + hstep, voffA);
            PG8_WAIT_L(8); PG8_BAR; PG8_WAIT_L(0); PG8_MMA(0, 0, At, B0); PG8_BAR; PG8_SCHED;
            PG8_LDB(B1, 1, 1); PG8_STAGE(PG8_SB(1, 0), b3, voffB);
            PG8_BAR; PG8_WAIT_L(0); PG8_MMA(0, 1, At, B1); PG8_BAR;
            PG8_LDA(At, 1, 1); PG8_STAGE(PG8_SA(1, 0), a3, voffA);
            PG8_BAR; PG8_WAIT_L(0); PG8_MMA(1, 0, At, B0); PG8_BAR; PG8_SCHED;
            PG8_STAGE(PG8_SB(1, 1), b3 + hstep, voffB);
            PG8_WAIT_V(6); PG8_BAR; PG8_MMA(1, 1, At, B1); PG8_BAR;
            }
        }
        if constexpr (ALIGN_EPI) { if (wr == 0) PG8_BAR; }
        if constexpr (!Epi::AFTER_DRAIN) { E(acc, cur, wr, wc, fr, fq, (const PG8_LAS float*)(lds + XSLOT_OFF + (ui & 1) * XSLOT_BYTES), (PG8_LAS float*)(lds + RED_OFF), pre); S.done(cur); }
        if (!has_next) break;
#pragma unroll
        for (int a = 0; a < 2; ++a)
#pragma unroll
            for (int b = 0; b < 2; ++b)
#pragma unroll
                for (int m = 0; m < 4; ++m)
#pragma unroll
                    for (int n = 0; n < 2; ++n) acc[a][b][m][n] = (f32x4){0.f, 0.f, 0.f, 0.f};
        cur = nxt; cA = nA; cB = nB; ++ui;
        if constexpr (ALIGN_EPI) { if (wr == 1) PG8_BAR; }
    }
    PG8_WAIT_V(0);
    if constexpr (!ALIGN_EPI) { if (wr == 0) PG8_BAR; }
    PG8_BAR;
#undef PG8_SA
#undef PG8_SB
#undef PG8_STAGE
#undef PG8_LDA
#undef PG8_LDB
#undef PG8_MMA
#undef PG8_WAIT_V
#undef PG8_WAIT_L
#undef PG8_BAR
#undef PG8_SCHED
}
}

constexpr int SEQ = 16384, MTOK = 32768, DM = 1024, DFF = 2816;
constexpr int EV_IN = 2304, OD_INP = 2048;
constexpr float ALPHA = 1.681792830507429f;
constexpr float LOG2E = 1.4426950408889634f;
constexpr size_t MiB = 1u << 20;
constexpr size_t OFF_WIN_EV = 0;
constexpr size_t OFF_WOUT_EV = OFF_WIN_EV + (size_t)2 * EV_IN * DM * 2;
constexpr size_t OFF_WIN_OD = OFF_WOUT_EV + (size_t)2 * DM * DM * 2;
constexpr size_t OFF_WOUT_OD = OFF_WIN_OD + (size_t)2 * OD_INP * DM * 2;
constexpr size_t OFF_WGU = OFF_WOUT_OD + (size_t)2 * DM * DM * 2;
constexpr size_t OFF_WDN = OFF_WGU + (size_t)4 * 2 * DFF * DM * 2;
constexpr size_t OFF_WUQ = OFF_WDN + (size_t)4 * DM * DFF * 2;
constexpr size_t OFF_WUKV = OFF_WUQ + (size_t)2 * 384 * 256 * 2;
constexpr size_t OFF_WEND = OFF_WUKV + (size_t)2 * 768 * 128 * 2;
static_assert(OFF_WEND <= 92 * MiB, "weights");
constexpr size_t OFF_XB = 92 * MiB;
constexpr size_t OFF_U = 156 * MiB;
constexpr size_t OFF_MIX = 300 * MiB;
constexpr size_t OFF_Q = 364 * MiB;
constexpr size_t OFF_KF = 388 * MiB;
constexpr size_t OFF_VT = 412 * MiB;
constexpr size_t OFF_GST = 444 * MiB;
constexpr size_t OFF_DVEC = 508 * MiB;
constexpr size_t OFF_H = 300 * MiB;
constexpr size_t OFF_CV = 509 * MiB;
constexpr size_t OFF_STATS = OFF_CV + 512 * 1024;
constexpr size_t OFF_PART = 300 * MiB;
constexpr int NFOLD = 2048 + 2304 + 2048 + 4 * 5632;
constexpr size_t OFF_CTL = 511 * MiB + 512 * 1024;
constexpr size_t CTL_BYTES = 16384;
constexpr size_t WS_NEED = 512 * MiB;
static_assert(OFF_STATS + (size_t)2 * 32768 * 8 * 4 <= OFF_CTL && (size_t)2 * NFOLD * 4 <= 512 * 1024, "ws map");
constexpr int LDS_BYTES = 160 * 1024;
constexpr int LDS_MISC_OFF = pg8::RED_OFF + 8192;

struct Args { const float* in[21]; float* out; unsigned char* ws; int ph_lo, ph_hi; };

typedef float f32x2_t __attribute__((ext_vector_type(2))); typedef __bf16 bf16x2_t __attribute__((ext_vector_type(2)));
DI unsigned short f2bf(float f) { const __bf16 b = (__bf16)f; return __builtin_bit_cast(unsigned short, b); }
DI float bf2f(unsigned short h) { return __builtin_bit_cast(float, (unsigned)h << 16); }
DI unsigned pk2(float lo, float hi) { const f32x2_t v = {lo, hi}; const bf16x2_t b = __builtin_convertvector(v, bf16x2_t); return __builtin_bit_cast(unsigned, b); }
DI float bflo(unsigned w) { return __builtin_bit_cast(float, w << 16); }
DI float bfhi(unsigned w) { return __builtin_bit_cast(float, w & 0xffff0000u); }
#define MFMA16(a, b, c) __builtin_amdgcn_mfma_f32_16x16x32_bf16((a), (b), (c), 0, 0, 0)
#define MFMA32(a, b, c) __builtin_amdgcn_mfma_f32_32x32x16_bf16((a), (b), (c), 0, 0, 0)
DI float fexp(float x) { return __builtin_amdgcn_exp2f(x * LOG2E); }
DI float silu(float x) { return x * __builtin_amdgcn_rcpf(1.f + __builtin_amdgcn_exp2f(-x * LOG2E)); }

DI int wt_map(int mode, int n) {
    if (mode == 1) return n < 1024 ? n : (n < 1040 ? 1952 + (n - 1024) : n - 16);
    if (mode == 2) return (n >> 7) * 256 + (n & 127);
    if (mode == 3) return (n >> 7) * 256 + 128 + (n & 127);
    return n;
}
DI void transpose_item(const float* W, int K, int N, bf16_t* WT, int mode, const float* gk, const float* bk, float* p1, float* p2, LAS float* scr, int item, int lane) {
    const int nblk = (N + 31) / 32, kb = item / nblk, nb = item % nblk, k0 = 64 * kb, n0 = 32 * nb;
    const int n = n0 + (lane & 31);
    float v[32];
#pragma unroll
    for (int i = 0; i < 32; ++i) { const int kk = 2 * i + (lane >> 5); v[i] = (n < N) ? W[(size_t)(k0 + kk) * N + n] : 0.f; }
#pragma unroll
    for (int i = 0; i < 32; ++i) { const int kk = 2 * i + (lane >> 5); scr[kk * 33 + (lane & 31)] = v[i]; }
    asm volatile("s_waitcnt lgkmcnt(0)" ::: "memory");
    const int c = lane & 7;
    f32x4 g0 = (f32x4){1.f, 1.f, 1.f, 1.f}, g1 = g0, b0 = (f32x4){0.f, 0.f, 0.f, 0.f}, b1 = b0;
    if (gk) { g0 = *(const f32x4*)(gk + k0 + 8 * c); g1 = *(const f32x4*)(gk + k0 + 8 * c + 4); }
    if (bk) { b0 = *(const f32x4*)(bk + k0 + 8 * c); b1 = *(const f32x4*)(bk + k0 + 8 * c + 4); }
#pragma unroll
    for (int j = 0; j < 4; ++j) { const int nn = (lane >> 3) + 8 * j; const LAS float* sp = scr + (8 * c) * 33 + nn;
        float w[8];
#pragma unroll
        for (int e = 0; e < 8; ++e) w[e] = sp[e * 33];
        u32x4 o; o.x = pk2(w[0] * g0[0], w[1] * g0[1]); o.y = pk2(w[2] * g0[2], w[3] * g0[3]); o.z = pk2(w[4] * g1[0], w[5] * g1[1]); o.w = pk2(w[6] * g1[2], w[7] * g1[3]);
        const bool ok = n0 + nn < N; const int dr = wt_map(mode, n0 + nn);
        if (ok) *(u32x4*)(WT + (size_t)dr * K + k0 + 8 * c) = o;
        if (p1) { float a1 = ((bflo(o.x) + bfhi(o.x)) + (bflo(o.y) + bfhi(o.y))) + ((bflo(o.z) + bfhi(o.z)) + (bflo(o.w) + bfhi(o.w)));
            float a2 = ((w[0] * b0[0] + w[1] * b0[1]) + (w[2] * b0[2] + w[3] * b0[3])) + ((w[4] * b1[0] + w[5] * b1[1]) + (w[6] * b1[2] + w[7] * b1[3]));
            a1 += __shfl_xor(a1, 1); a1 += __shfl_xor(a1, 2); a1 += __shfl_xor(a1, 4); a2 += __shfl_xor(a2, 1); a2 += __shfl_xor(a2, 2); a2 += __shfl_xor(a2, 4);
            if (c == 0 && ok) { p1[(size_t)kb * NFOLD + dr] = a1; p2[(size_t)kb * NFOLD + dr] = a2; } } }
    asm volatile("s_waitcnt lgkmcnt(0)" ::: "memory");
}
DI int fold_off(int fm) { return fm == 0 ? 0 : fm == 1 ? 2048 : fm == 2 ? 4352 : 6400 + (fm - 3) * 5632; }
DI void prologue_phase(const Args& a, LAS unsigned char* lds) {
    const int tid = opq_tid(), lane = tid & 63, w = tid >> 6;
    LAS float* scr = (LAS float*)(lds + w * 8704);
    const int gw = opq_bid() * 8 + w, NGW = gridDim.x * 8;
    unsigned char* ws = a.ws;
    float* P1 = (float*)(ws + OFF_PART); float* P2 = P1 + (size_t)16 * NFOLD;
    int base = 0;
    for (int mat = 0; mat < 24; ++mat) {
        const float* W; int K, N, mode = 0; bf16_t* WT; const float* gk = nullptr; const float* bk = nullptr; int fm = -1;
        if (mat < 2)       { const int i = mat;      W = a.in[1] + (size_t)i * DM * EV_IN;  K = DM; N = EV_IN; WT = (bf16_t*)(ws + OFF_WIN_EV) + (size_t)i * EV_IN * DM; if (i == 1) { fm = 1; gk = a.in[19] + 1 * DM; bk = a.in[20] + 1 * DM; } }
        else if (mat < 4)  { const int i = mat - 2;  W = a.in[4] + (size_t)i * DM * DM;     K = DM; N = DM;    WT = (bf16_t*)(ws + OFF_WOUT_EV) + (size_t)i * DM * DM; }
        else if (mat < 6)  { const int i = mat - 4;  W = a.in[5] + (size_t)i * DM * 1968;   K = DM; N = 1968;  WT = (bf16_t*)(ws + OFF_WIN_OD) + (size_t)i * OD_INP * DM; mode = 1; fm = i ? 2 : 0; gk = a.in[19] + (size_t)(2 * i) * DM; bk = a.in[20] + (size_t)(2 * i) * DM; }
        else if (mat < 8)  { const int i = mat - 6;  W = a.in[13] + (size_t)i * DM * DM;    K = DM; N = DM;    WT = (bf16_t*)(ws + OFF_WOUT_OD) + (size_t)i * DM * DM; }
        else if (mat < 12) { const int l = mat - 8;  W = a.in[14] + (size_t)l * DM * DFF;   K = DM; N = DFF;   WT = (bf16_t*)(ws + OFF_WGU) + (size_t)l * 2 * DFF * DM; mode = 2; fm = 3 + l; gk = a.in[17] + (size_t)l * DM; bk = a.in[18] + (size_t)l * DM; }
        else if (mat < 16) { const int l = mat - 12; W = a.in[15] + (size_t)l * DM * DFF;   K = DM; N = DFF;   WT = (bf16_t*)(ws + OFF_WGU) + (size_t)l * 2 * DFF * DM; mode = 3; fm = 3 + l; gk = a.in[17] + (size_t)l * DM; bk = a.in[18] + (size_t)l * DM; }
        else if (mat < 20) { const int l = mat - 16; W = a.in[16] + (size_t)l * DFF * DM;   K = DFF; N = DM;   WT = (bf16_t*)(ws + OFF_WDN) + (size_t)l * DM * DFF; }
        else if (mat < 22) { const int i = mat - 20; W = a.in[10] + (size_t)i * 256 * 384;  K = 256; N = 384;  WT = (bf16_t*)(ws + OFF_WUQ) + (size_t)i * 384 * 256; gk = a.in[9] + i * 256; }
        else               { const int i = mat - 22; W = a.in[12] + (size_t)i * 128 * 768;  K = 128; N = 768;  WT = (bf16_t*)(ws + OFF_WUKV) + (size_t)i * 768 * 128; gk = a.in[11] + i * 128; }
        float* p1 = fm >= 0 ? P1 + fold_off(fm) : nullptr; float* p2 = fm >= 0 ? P2 + fold_off(fm) : nullptr;
        const int nitems = (K / 64) * ((N + 31) / 32);
        int it = gw - (base % NGW); if (it < 0) it += NGW;
        for (; it < nitems; it += NGW) transpose_item(W, K, N, WT, mode, gk, bk, p1, p2, scr, it, lane);
        base += nitems;
    }
    { const int gt = opq_bid() * 512 + tid, NT = gridDim.x * 512;
      for (int e = gt; e < 2 * 80 * 128; e += NT) { const int i = e / (80 * 128), r = (e / 128) % 80, c = e % 128;
          unsigned oz_ = 0u; asm volatile("" : "+v"(oz_));
          *(u32x4*)((bf16_t*)(ws + OFF_WIN_OD) + ((size_t)i * OD_INP + 1968 + r) * DM + 8 * c) = (u32x4){oz_, oz_, oz_, oz_}; }
      const float* x = a.in[0]; bf16_t* xb = (bf16_t*)(ws + OFF_XB);
      for (size_t e = gt; e < (size_t)MTOK * DM / 8; e += (size_t)4 * NT) {
          f32x4 v0[4], v1[4];
#pragma unroll
          for (int j = 0; j < 4; ++j) { const size_t ee = e + (size_t)j * NT; if (ee < (size_t)MTOK * DM / 8) { v0[j] = *(const f32x4*)(x + ee * 8); v1[j] = *(const f32x4*)(x + ee * 8 + 4); } }
#pragma unroll
          for (int j = 0; j < 4; ++j) { const size_t ee = e + (size_t)j * NT; if (ee < (size_t)MTOK * DM / 8) {
              u32x4 o; o.x = pk2(v0[j][0], v0[j][1]); o.y = pk2(v0[j][2], v0[j][3]); o.z = pk2(v1[j][0], v1[j][1]); o.w = pk2(v1[j][2], v1[j][3]); *(u32x4*)(xb + ee * 8) = o; } } } }
}
DI void fold_reduce(const Args& a) {
    const int gt = opq_bid() * 512 + opq_tid(), NT = gridDim.x * 512;
    const float* P1 = (const float*)(a.ws + OFF_PART); const float* P2 = P1 + (size_t)16 * NFOLD;
    float* C1 = (float*)(a.ws + OFF_CV); float* C2 = C1 + NFOLD;
    for (int n = gt; n < NFOLD; n += NT) {
        const bool pad = (n >= 1968 && n < 2048) || (n >= 4352 + 1968 && n < 4352 + 2048);
        float s1 = 0.f, s2 = 0.f;
        if (!pad) {
#pragma unroll
            for (int kb = 0; kb < 16; ++kb) { s1 += P1[(size_t)kb * NFOLD + n]; s2 += P2[(size_t)kb * NFOLD + n]; } }
        C1[n] = s1; C2[n] = s2;
    }
}

DI float wave_sum(float v) {
#pragma unroll
    for (int o = 1; o < 64; o <<= 1) v += __shfl_xor(v, o);
    return v;
}
DI void ln_phase(const float* Xin, float* X, const float* g, const float* b, bf16_t* XB) {
    const int tid = opq_tid(), lane = tid & 63, w = tid >> 6;
    const int gw = opq_bid() * 8 + w, NGW = gridDim.x * 8;
    f32x4 gv[4], bv[4];
#pragma unroll
    for (int j = 0; j < 4; ++j) { gv[j] = *(const f32x4*)(g + lane * 4 + 256 * j); bv[j] = *(const f32x4*)(b + lane * 4 + 256 * j); }
    f32x4 vn[4];
    if (gw < MTOK) {
#pragma unroll
        for (int j = 0; j < 4; ++j) vn[j] = *(const f32x4*)(Xin + (size_t)gw * DM + lane * 4 + 256 * j); }
    for (int m = gw; m < MTOK; m += NGW) {
        float* xr = X + (size_t)m * DM + lane * 4;
        f32x4 v[4]; float s = 0.f;
#pragma unroll
        for (int j = 0; j < 4; ++j) { v[j] = vn[j]; s += (v[j][0] + v[j][1]) + (v[j][2] + v[j][3]); }
        if (m + NGW < MTOK) {
#pragma unroll
            for (int j = 0; j < 4; ++j) vn[j] = *(const f32x4*)(Xin + (size_t)(m + NGW) * DM + lane * 4 + 256 * j); }
        const float mean = wave_sum(s) * (1.f / DM); float s2 = 0.f;
#pragma unroll
        for (int j = 0; j < 4; ++j) { v[j] = v[j] - mean; s2 += (v[j][0] * v[j][0] + v[j][1] * v[j][1]) + (v[j][2] * v[j][2] + v[j][3] * v[j][3]); }
        const float rstd = __builtin_amdgcn_rsqf(wave_sum(s2) * (1.f / DM) + 1e-5f);
#pragma unroll
        for (int j = 0; j < 4; ++j) { const f32x4 o = v[j] * rstd * gv[j] + bv[j]; *(f32x4*)(xr + 256 * j) = o;
            if (XB) { u32x2 p; p.x = pk2(o[0], o[1]); p.y = pk2(o[2], o[3]); *(u32x2*)(XB + (size_t)m * DM + lane * 4 + 256 * j) = p; } }
    }
}

DI void conv_phase(const bf16_t* U, const float* cw  , bf16_t* MIX) {
    const int gt = opq_bid() * 512 + opq_tid(), NT = gridDim.x * 512;
    for (int id = gt; id < MTOK * 64; id += NT) {
        const int t = id >> 6, c8 = (id & 63) * 8, tl = t & (SEQ - 1);
        const bf16_t* row = U + (size_t)t * EV_IN;
        float acc[8];
#pragma unroll
        for (int e = 0; e < 8; ++e) acc[e] = 0.f;
#pragma unroll
        for (int j = 0; j < 3; ++j) {
            if (tl - 2 + j >= 0) {
                const bf16_t* r2 = row - (size_t)(2 - j) * EV_IN;
                const u32x4 cg = *(const u32x4*)(r2 + 512 + c8), hh = *(const u32x4*)(r2 + 1024 + c8);
                const f32x4 w0 = *(const f32x4*)(cw + j * 512 + c8), w1 = *(const f32x4*)(cw + j * 512 + c8 + 4);
#pragma unroll
                for (int p = 0; p < 4; ++p) { const float wl = p < 2 ? w0[2 * p] : w1[2 * p - 4], wh = p < 2 ? w0[2 * p + 1] : w1[2 * p - 3];
                    acc[2 * p] += wl * (bflo(cg[p]) * bflo(hh[p])); acc[2 * p + 1] += wh * (bfhi(cg[p]) * bfhi(hh[p])); }
            }
        }
        const u32x4 bg = *(const u32x4*)(row + c8);
        u32x4 o;
#pragma unroll
        for (int p = 0; p < 4; ++p) o[p] = pk2(bflo(bg[p]) * acc[2 * p], bfhi(bg[p]) * acc[2 * p + 1]);
        *(u32x4*)(MIX + (size_t)t * DM + c8) = o;
    }
}
DI void swa_phase(LAS unsigned char* lds, const bf16_t* U, const float* sinks, bf16_t* MIX) {
    const int tid = opq_tid(), lane = tid & 63, w = tid >> 6, l16 = lane & 15, g = lane >> 4;
    constexpr int KP = 72, VP = 280;
    LAS bf16_t* Ks = (LAS bf16_t*)lds;
    LAS bf16_t* Vt = (LAS bf16_t*)(lds + 256 * KP * 2);
    for (int unit = opq_bid(); unit < 512; unit += gridDim.x) {
        const int hk = unit & 1, n = (unit >> 1) & 127, b = unit >> 8;
        const long tok0 = (long)b * SEQ + (long)n * 128;
#pragma unroll 1
        for (int i = 0; i < 4; ++i) { const int id = tid + 512 * i, kk = id >> 3, c = id & 7;
            u32x4 kv = (u32x4){0u, 0u, 0u, 0u}, vv = (u32x4){0u, 0u, 0u, 0u};
            if (n > 0 || kk >= 128) { const bf16_t* row = U + (size_t)(tok0 - 128 + kk) * EV_IN; kv = *(const u32x4*)(row + 2048 + hk * 64 + 8 * c); vv = *(const u32x4*)(row + 2176 + hk * 64 + 8 * c); }
            *(LAS u32x4*)(Ks + kk * KP + 8 * c) = kv;
#pragma unroll
            for (int e = 0; e < 8; ++e) Vt[(8 * c + e) * VP + kk] = (bf16_t)(vv[e >> 1] >> (16 * (e & 1)));
        }
#pragma unroll
        for (int i = 0; i < 2; ++i) { const int id = tid + 512 * i; Vt[(id >> 4) * VP + 256 + (id & 15)] = 0; }
        __syncthreads();
#pragma unroll 1
        for (int gi = 0; gi < 4; ++gi) {
            const int hq = hk * 4 + gi;
            const long qtok = tok0 + 16 * w + l16;
            const bf16_t* qrow = U + (size_t)qtok * EV_IN + 1536 + hq * 64 + 8 * g;
            const bf16x8 q0 = *(const bf16x8*)qrow, q1 = *(const bf16x8*)(qrow + 32);
            f32x4 s[10];
#pragma unroll
            for (int i = 0; i < 9; ++i) { const LAS bf16_t* kp = Ks + (16 * (w + i) + l16) * KP + 8 * g;
                const bf16x8 k0 = *(const LAS bf16x8*)kp, k1 = *(const LAS bf16x8*)(kp + 32);
                f32x4 acc = (f32x4){0.f, 0.f, 0.f, 0.f}; acc = MFMA16(k0, q0, acc); acc = MFMA16(k1, q1, acc); s[i] = acc; if ((i % 3) == 2) __builtin_amdgcn_sched_barrier(0); }
            s[9] = (f32x4){0.f, 0.f, 0.f, 0.f};
            const int qi = 16 * w + l16; const float sc = 0.125f * LOG2E, sink2 = sinks[hq] * LOG2E;
            float mx = -INFINITY;
#pragma unroll
            for (int i = 0; i < 9; ++i)
#pragma unroll
                for (int r = 0; r < 4; ++r) { const int kk = 16 * (w + i) + 4 * g + r; const bool ok = (kk > qi) && (kk <= qi + 128) && (n > 0 || kk >= 128);
                    const float v = ok ? s[i][r] * sc : -INFINITY; s[i][r] = v; mx = fmaxf(mx, v); }
            mx = fmaxf(mx, __shfl_xor(mx, 16)); mx = fmaxf(mx, __shfl_xor(mx, 32));
            const float m = fmaxf(mx, sink2); float sum = 0.f;
#pragma unroll
            for (int i = 0; i < 9; ++i)
#pragma unroll
                for (int r = 0; r < 4; ++r) { const float p = __builtin_amdgcn_exp2f(s[i][r] - m); s[i][r] = p; sum += p; }
            sum += __shfl_xor(sum, 16); sum += __shfl_xor(sum, 32);
            const float inv = __builtin_amdgcn_rcpf(sum + __builtin_amdgcn_exp2f(sink2 - m));
            f32x4 o[4];
#pragma unroll
            for (int mt = 0; mt < 4; ++mt) o[mt] = (f32x4){0.f, 0.f, 0.f, 0.f};
#pragma unroll
            for (int ks = 0; ks < 5; ++ks) {
                u32x4 pw; pw.x = pk2(s[2 * ks][0], s[2 * ks][1]); pw.y = pk2(s[2 * ks][2], s[2 * ks][3]); pw.z = pk2(s[2 * ks + 1][0], s[2 * ks + 1][1]); pw.w = pk2(s[2 * ks + 1][2], s[2 * ks + 1][3]);
                const bf16x8 pb = __builtin_bit_cast(bf16x8, pw);
#pragma unroll
                for (int mt = 0; mt < 4; ++mt) { const LAS bf16_t* vp = Vt + (16 * mt + l16) * VP + 16 * (w + 2 * ks) + 4 * g;
                    const s16x4 lo = *(const LAS s16x4*)vp, hi = *(const LAS s16x4*)(vp + 16);
                    const bf16x8 va = __builtin_shufflevector(lo, hi, 0, 1, 2, 3, 4, 5, 6, 7);
                    o[mt] = MFMA16(va, pb, o[mt]); }
                __builtin_amdgcn_sched_barrier(0);
            }
            bf16_t* orow = MIX + (size_t)qtok * DM + 512 + hq * 64 + 4 * g;
#pragma unroll
            for (int mt = 0; mt < 4; ++mt) { u32x2 p; p.x = pk2(o[mt][0] * inv, o[mt][1] * inv); p.y = pk2(o[mt][2] * inv, o[mt][3] * inv); *(u32x2*)(orow + 16 * mt) = p; }
        }
        __syncthreads();
    }
}

DI void rope_cs(int pos, int i, float& c, float& s) {
    const float invf = __builtin_amdgcn_exp2f(-(float)i * 0.8304820237218406f);
    const float ang = (float)pos * invf;
    const float k = __builtin_rintf(ang * 0.15915494309189535f);
    float r = fmaf(-k, 6.28125f, ang); r = fmaf(-k, 0.0019353071795864769f, r);
    const float fr = r * 0.15915494309189535f;
    s = __builtin_amdgcn_sinf(fr); c = __builtin_amdgcn_cosf(fr);
}
DI void mla_prep_phase(LAS unsigned char* lds, const bf16_t* U, const bf16_t* Wuq, const bf16_t* Wukv, bf16_t* Qg, bf16_t* Kg, bf16_t* Vtg) {
    const int tid = opq_tid(), lane = tid & 63, w = tid >> 6, l16 = lane & 15, g = lane >> 4;
    constexpr int QP = 264, CP = 136;
    LAS bf16_t* Aq = (LAS bf16_t*)lds;
    LAS bf16_t* Akv = (LAS bf16_t*)(lds + 64 * QP * 2);
    LAS float* rq = (LAS float*)(lds + 64 * QP * 2 + 64 * CP * 2);
    LAS float* rkv = rq + 64;
    LAS bf16_t* Vst = (LAS bf16_t*)(lds + 64 * QP * 2 + 64 * CP * 2 + 512);
    const float QSCALE = 0.10206207261596577f * LOG2E;
    for (int unit = opq_bid(); unit < 512; unit += gridDim.x) {
        const int row0 = unit * 64, b = row0 >> 14, s0 = row0 & (SEQ - 1);
#pragma unroll
        for (int i = 0; i < 4; ++i) { const int id = tid + 512 * i, r = id >> 5, c = id & 31;
            *(LAS u32x4*)(Aq + r * QP + 8 * c) = *(const u32x4*)(U + (size_t)(row0 + r) * OD_INP + 1536 + 8 * c); }
#pragma unroll
        for (int i = 0; i < 2; ++i) { const int id = tid + 512 * i, r = id >> 4, c = id & 15;
            *(LAS u32x4*)(Akv + r * CP + 8 * c) = *(const u32x4*)(U + (size_t)(row0 + r) * OD_INP + 1792 + 8 * c); }
#pragma unroll
        for (int i = 0; i < 2; ++i) { const int id = tid + 512 * i, r = id >> 4, p = id & 15; const int pos = s0 + r;
            const bf16_t* kr = U + (size_t)(row0 + r) * OD_INP + 1920; const float t1 = bf2f(kr[p]), t2 = bf2f(kr[16 + p]);
            float c, s; rope_cs(pos, p, c, s); const bf16_t o1 = f2bf(t1 * c - t2 * s), o2 = f2bf(t2 * c + t1 * s);
#pragma unroll
            for (int hh = 0; hh < 4; ++hh) { bf16_t* kd = Kg + ((size_t)(b * 4 + hh) * SEQ + pos) * 96 + 64; kd[p] = o1; kd[16 + p] = o2; } }
        __syncthreads();
        { const int r = tid >> 3, part = tid & 7; float ss = 0.f;
#pragma unroll
          for (int e = 0; e < 32; ++e) { const float v = bf2f(Aq[r * QP + part * 32 + e]); ss += v * v; }
          ss += __shfl_xor(ss, 1); ss += __shfl_xor(ss, 2); ss += __shfl_xor(ss, 4);
          float s2 = 0.f;
#pragma unroll
          for (int e = 0; e < 16; ++e) { const float v = bf2f(Akv[r * CP + part * 16 + e]); s2 += v * v; }
          s2 += __shfl_xor(s2, 1); s2 += __shfl_xor(s2, 2); s2 += __shfl_xor(s2, 4);
          if (part == 0) { rq[r] = __builtin_amdgcn_rsqf(ss * (1.f / 256.f) + 1e-6f); rkv[r] = __builtin_amdgcn_rsqf(s2 * (1.f / 128.f) + 1e-6f); } }
        __syncthreads();
        const int hh = w & 3, nt0 = (w >> 2) * 2;
        {
            f32x4 acc[6][2];
#pragma unroll
            for (int mt = 0; mt < 6; ++mt) { acc[mt][0] = (f32x4){0.f, 0.f, 0.f, 0.f}; acc[mt][1] = (f32x4){0.f, 0.f, 0.f, 0.f}; }
#pragma unroll 4
            for (int ks = 0; ks < 8; ++ks) {
                bf16x8 bfr[2];
#pragma unroll
                for (int j = 0; j < 2; ++j) bfr[j] = *(const LAS bf16x8*)(Aq + (16 * (nt0 + j) + l16) * QP + 32 * ks + 8 * g);
#pragma unroll
                for (int mt = 0; mt < 6; ++mt) { const bf16x8 af = *(const bf16x8*)(Wuq + (size_t)(96 * hh + 16 * mt + l16) * 256 + 32 * ks + 8 * g);
                    acc[mt][0] = MFMA16(af, bfr[0], acc[mt][0]); acc[mt][1] = MFMA16(af, bfr[1], acc[mt][1]); }
            }
#pragma unroll
            for (int j = 0; j < 2; ++j) { const int tokl = 16 * (nt0 + j) + l16, pos = s0 + tokl; const float rs = rq[tokl] * QSCALE;
                bf16_t* qo = Qg + ((size_t)(b * 4 + hh) * SEQ + pos) * 96;
#pragma unroll
                for (int mt = 0; mt < 4; ++mt) { u32x2 p; p.x = pk2(acc[mt][j][0] * rs, acc[mt][j][1] * rs); p.y = pk2(acc[mt][j][2] * rs, acc[mt][j][3] * rs); *(u32x2*)(qo + 16 * mt + 4 * g) = p; }
                float o1[4], o2[4];
#pragma unroll
                for (int r = 0; r < 4; ++r) { float c, s; rope_cs(pos, 4 * g + r, c, s); const float t1 = acc[4][j][r] * rs, t2 = acc[5][j][r] * rs; o1[r] = t1 * c - t2 * s; o2[r] = t2 * c + t1 * s; }
                u32x2 p1, p2; p1.x = pk2(o1[0], o1[1]); p1.y = pk2(o1[2], o1[3]); p2.x = pk2(o2[0], o2[1]); p2.y = pk2(o2[2], o2[3]);
                *(u32x2*)(qo + 64 + 4 * g) = p1; *(u32x2*)(qo + 80 + 4 * g) = p2; }
        }
#pragma unroll 1
        for (int grp = 0; grp < 3; ++grp) {
            f32x4 acc[4][2];
#pragma unroll
            for (int mt = 0; mt < 4; ++mt) { acc[mt][0] = (f32x4){0.f, 0.f, 0.f, 0.f}; acc[mt][1] = (f32x4){0.f, 0.f, 0.f, 0.f}; }
#pragma unroll
            for (int ks = 0; ks < 4; ++ks) {
                bf16x8 bfr[2];
#pragma unroll
                for (int j = 0; j < 2; ++j) bfr[j] = *(const LAS bf16x8*)(Akv + (16 * (nt0 + j) + l16) * CP + 32 * ks + 8 * g);
#pragma unroll
                for (int mt = 0; mt < 4; ++mt) { const bf16x8 af = *(const bf16x8*)(Wukv + (size_t)(192 * hh + 64 * grp + 16 * mt + l16) * 128 + 32 * ks + 8 * g);
                    acc[mt][0] = MFMA16(af, bfr[0], acc[mt][0]); acc[mt][1] = MFMA16(af, bfr[1], acc[mt][1]); }
            }
#pragma unroll
            for (int j = 0; j < 2; ++j) { const int tokl = 16 * (nt0 + j) + l16, pos = s0 + tokl; const float rs = rkv[tokl];
                const int tokp = 16 * (nt0 + j) + 8 * ((l16 >> 2) & 1) + 4 * (l16 >> 3) + (l16 & 3);
                if (grp == 0) { bf16_t* ko = Kg + ((size_t)(b * 4 + hh) * SEQ + pos) * 96;
#pragma unroll
                    for (int mt = 0; mt < 4; ++mt) { u32x2 p; p.x = pk2(acc[mt][j][0] * rs, acc[mt][j][1] * rs); p.y = pk2(acc[mt][j][2] * rs, acc[mt][j][3] * rs); *(u32x2*)(ko + 16 * mt + 4 * g) = p; } }
                else {
#pragma unroll
                    for (int mt = 0; mt < 4; ++mt)
#pragma unroll
                        for (int r = 0; r < 4; ++r) { const int dv = 64 * (grp - 1) + 16 * mt + 4 * g + r; Vst[(hh * 128 + dv) * 72 + tokp] = f2bf(acc[mt][j][r] * rs); } } }
        }
        __syncthreads();
#pragma unroll
        for (int i = 0; i < 8; ++i) { const int id = tid + 512 * i, row = id >> 3, c = id & 7;
            *(u32x4*)(Vtg + ((size_t)(b * 4 + (row >> 7)) * 128 + (row & 127)) * SEQ + s0 + 8 * c) = *(const LAS u32x4*)(Vst + row * 72 + 8 * c); }
        __syncthreads();
    }
}

DI void gla_gates(const bf16_t* Urow0, const float* wg, const float* bg, int h, LAS float* tot, float (&bc)[8], float& total, int tid) {
    const int d = tid & 63, seg = tid >> 6, col = h * 64 + d;
    float wr[16];
#pragma unroll
    for (int r = 0; r < 16; ++r) wr[r] = wg[r * 256 + col];
    const float bias = bg[col]; float run = 0.f;
#pragma unroll
    for (int tt = 0; tt < 8; ++tt) { const bf16_t* gl = Urow0 + (size_t)(8 * seg + tt) * OD_INP + 1952;
        const u32x4 a0 = *(const u32x4*)gl, a1 = *(const u32x4*)(gl + 8); float z = bias;
#pragma unroll
        for (int p = 0; p < 4; ++p) { z += bflo(a0[p]) * wr[2 * p] + bfhi(a0[p]) * wr[2 * p + 1]; z += bflo(a1[p]) * wr[8 + 2 * p] + bfhi(a1[p]) * wr[9 + 2 * p]; }
        const float ls = -(fmaxf(-z, 0.f) + __builtin_amdgcn_logf(1.f + fexp(-fabsf(z))) * 0.6931471805599453f);
        run += ls * (1.f / 16.f); bc[tt] = run; }
    tot[seg * 64 + d] = run; __syncthreads();
    float prefix = 0.f; total = 0.f;
#pragma unroll
    for (int s = 0; s < 8; ++s) { const float v = tot[s * 64 + d]; total += v; if (s < seg) prefix += v; }
#pragma unroll
    for (int tt = 0; tt < 8; ++tt) bc[tt] += prefix;
}
DI void gla_vt_load(u32x4 (&vv)[2], const bf16_t* Urow0, int h, int tid) {
#pragma unroll
    for (int i = 0; i < 2; ++i) { const int id = tid + 512 * i, t = id & 63, c8 = id >> 6; vv[i] = *(const u32x4*)(Urow0 + (size_t)t * OD_INP + 512 + h * 128 + 8 * c8); }
}
DI void gla_vt_store(LAS bf16_t* Vt, const u32x4 (&vv)[2], int tid) {
#pragma unroll
    for (int i = 0; i < 2; ++i) { const int id = tid + 512 * i, t = id & 63, c8 = id >> 6;
#pragma unroll
        for (int e = 0; e < 8; ++e) Vt[(8 * c8 + e) * 72 + t] = (bf16_t)(vv[i][e >> 1] >> (16 * (e & 1))); }
}
DI void gla_local_phase(LAS unsigned char* lds, const bf16_t* U, const float* wg, const float* bg, float* GST, float* DVEC) {
    const int tid = opq_tid(), lane = tid & 63, w = tid >> 6, l16 = lane & 15, g = lane >> 4, d = tid & 63, seg = tid >> 6;
    LAS float* tot = (LAS float*)lds; LAS bf16_t* Kt = (LAS bf16_t*)(lds + 2048); LAS bf16_t* Vt = (LAS bf16_t*)(lds + 2048 + 9216);
    for (int unit = opq_bid(); unit < 2048; unit += gridDim.x) {
        const int c = unit & 255, bh = unit >> 8, b = bh >> 2, h = bh & 3;
        const bf16_t* Urow0 = U + ((size_t)b * SEQ + (size_t)c * 64) * OD_INP;
        u32x4 vv[2]; gla_vt_load(vv, Urow0, h, tid);
        bf16_t kraw[8];
#pragma unroll
        for (int tt = 0; tt < 8; ++tt) kraw[tt] = Urow0[(size_t)(8 * seg + tt) * OD_INP + 256 + h * 64 + d];
        float bc[8], total; gla_gates(Urow0, wg, bg, h, tot, bc, total, tid);
        float kd[8];
#pragma unroll
        for (int tt = 0; tt < 8; ++tt) kd[tt] = bf2f(kraw[tt]) * fexp(total - bc[tt]);
        u32x4 pk; pk.x = pk2(kd[0], kd[1]); pk.y = pk2(kd[2], kd[3]); pk.z = pk2(kd[4], kd[5]); pk.w = pk2(kd[6], kd[7]);
        *(LAS u32x4*)(Kt + d * 72 + 8 * seg) = pk;
        if (seg == 0) DVEC[(size_t)unit * 64 + d] = fexp(total);
        gla_vt_store(Vt, vv, tid);
        __syncthreads();
        const int mt = w & 3; f32x4 acc[4];
#pragma unroll
        for (int j = 0; j < 4; ++j) acc[j] = (f32x4){0.f, 0.f, 0.f, 0.f};
#pragma unroll
        for (int ks = 0; ks < 2; ++ks) { const bf16x8 af = *(const LAS bf16x8*)(Kt + (16 * mt + l16) * 72 + 32 * ks + 8 * g);
#pragma unroll
            for (int j = 0; j < 4; ++j) { const int nt = (w >> 2) * 4 + j; const bf16x8 bfr = *(const LAS bf16x8*)(Vt + (16 * nt + l16) * 72 + 32 * ks + 8 * g); acc[j] = MFMA16(bfr, af, acc[j]); } }
#pragma unroll
        for (int j = 0; j < 4; ++j) { const int nt = (w >> 2) * 4 + j; u32x2 pw; pw.x = pk2(acc[j][0], acc[j][1]); pw.y = pk2(acc[j][2], acc[j][3]);
            *(u32x2*)((bf16_t*)GST + ((size_t)unit * 64 + 16 * mt + l16) * 128 + 16 * nt + 4 * g) = pw; }
        __syncthreads();
    }
}
DI void gla_scan_phase(float* GST, const float* DVEC, float* GOUT) {
    const int tid = opq_tid();
    if (tid < 128) {
        for (int e = opq_bid() * 128 + tid; e < 32768; e += gridDim.x * 128) {
            const int bh = e >> 12, rem2 = e & 4095, dk = rem2 >> 6;
            const unsigned* p = (const unsigned*)GST + (size_t)bh * 256 * 4096 + rem2; unsigned* po = (unsigned*)GOUT + (size_t)bh * 256 * 4096 + rem2; const float* dv = DVEC + (size_t)bh * 256 * 64 + dk;
            float S0 = 0.f, S1 = 0.f;
            for (int c = 0; c < 256; c += 16) { unsigned t[16]; float dd[16];
#pragma unroll
                for (int j = 0; j < 16; ++j) { t[j] = p[(size_t)(c + j) * 4096]; dd[j] = dv[(c + j) * 64]; }
#pragma unroll
                for (int j = 0; j < 16; ++j) { po[(size_t)(c + j) * 4096] = pk2(S0, S1); S0 = dd[j] * S0 + bflo(t[j]); S1 = dd[j] * S1 + bfhi(t[j]); } }
        }
    }
}
DI void gla_out_phase(LAS unsigned char* lds, const bf16_t* U, const float* wg, const float* bg, const float* gnorm, const float* GST, bf16_t* MIX) {
    const int tid = opq_tid(), lane = tid & 63, w = tid >> 6, l16 = lane & 15, g = lane >> 4, d = tid & 63, seg = tid >> 6;
    LAS float* tot = (LAS float*)lds; LAS bf16_t* Qs = (LAS bf16_t*)(lds + 2048); LAS bf16_t* Ks = (LAS bf16_t*)(lds + 11264);
    LAS bf16_t* Vt = (LAS bf16_t*)(lds + 20480); LAS bf16_t* St = (LAS bf16_t*)(lds + 38912); LAS bf16_t* Ps = (LAS bf16_t*)(lds + 57344);
    LAS float* Os = (LAS float*)(lds + 66560);
    for (int unit = opq_bid(); unit < 2048; unit += gridDim.x) {
        const int c = unit & 255, bh = unit >> 8, b = bh >> 2, h = bh & 3;
        const size_t tok0 = (size_t)b * SEQ + (size_t)c * 64;
        const bf16_t* Urow0 = U + tok0 * OD_INP;
        u32x4 vv[2]; gla_vt_load(vv, Urow0, h, tid);
        bf16_t qraw[8], kraw[8]; u32x4 stv[2];
#pragma unroll
        for (int tt = 0; tt < 8; ++tt) { const bf16_t* row = Urow0 + (size_t)(8 * seg + tt) * OD_INP; qraw[tt] = row[h * 64 + d]; kraw[tt] = row[256 + h * 64 + d]; }
#pragma unroll
        for (int i = 0; i < 2; ++i) { const int id = tid + 512 * i, dk = id & 63, c8 = id >> 6; stv[i] = *(const u32x4*)((const bf16_t*)GST + ((size_t)unit * 64 + dk) * 128 + 8 * c8); }
        float bc[8], total; gla_gates(Urow0, wg, bg, h, tot, bc, total, tid);
#pragma unroll
        for (int tt = 0; tt < 8; ++tt) { const int t = 8 * seg + tt;
            Qs[t * 72 + d] = f2bf(bf2f(qraw[tt]) * 0.125f * fexp(bc[tt])); Ks[t * 72 + d] = f2bf(bf2f(kraw[tt]) * fexp(-bc[tt])); }
        gla_vt_store(Vt, vv, tid);
#pragma unroll
        for (int i = 0; i < 2; ++i) { const int id = tid + 512 * i, dk = id & 63, c8 = id >> 6;
#pragma unroll
            for (int e = 0; e < 8; ++e) St[(8 * c8 + e) * 72 + dk] = (bf16_t)(stv[i][e >> 1] >> (16 * (e & 1))); }
        __syncthreads();
        const int mt = w & 3;
#pragma unroll
        for (int j = 0; j < 2; ++j) { const int nt = (w >> 2) * 2 + j; f32x4 acc = (f32x4){0.f, 0.f, 0.f, 0.f};
#pragma unroll
            for (int ks = 0; ks < 2; ++ks) { const bf16x8 af = *(const LAS bf16x8*)(Qs + (16 * mt + l16) * 72 + 32 * ks + 8 * g), bfr = *(const LAS bf16x8*)(Ks + (16 * nt + l16) * 72 + 32 * ks + 8 * g); acc = MFMA16(af, bfr, acc); }
#pragma unroll
            for (int r = 0; r < 4; ++r) { const int t = 16 * mt + 4 * g + r, s = 16 * nt + l16; Ps[t * 72 + s] = f2bf(s <= t ? acc[r] : 0.f); } }
        __syncthreads();
        { f32x4 o[4];
#pragma unroll
          for (int j = 0; j < 4; ++j) o[j] = (f32x4){0.f, 0.f, 0.f, 0.f};
#pragma unroll
          for (int ks = 0; ks < 2; ++ks) { const bf16x8 aq = *(const LAS bf16x8*)(Qs + (16 * mt + l16) * 72 + 32 * ks + 8 * g), ap = *(const LAS bf16x8*)(Ps + (16 * mt + l16) * 72 + 32 * ks + 8 * g);
#pragma unroll
              for (int j = 0; j < 4; ++j) { const int nt = (w >> 2) * 4 + j; const bf16x8 bs = *(const LAS bf16x8*)(St + (16 * nt + l16) * 72 + 32 * ks + 8 * g), bv = *(const LAS bf16x8*)(Vt + (16 * nt + l16) * 72 + 32 * ks + 8 * g);
                  o[j] = MFMA16(aq, bs, o[j]); o[j] = MFMA16(ap, bv, o[j]); } }
#pragma unroll
          for (int j = 0; j < 4; ++j) { const int nt = (w >> 2) * 4 + j;
#pragma unroll
              for (int r = 0; r < 4; ++r) Os[(16 * mt + 4 * g + r) * 132 + 16 * nt + l16] = o[j][r]; } }
        __syncthreads();
        { const int t = tid >> 3, part = tid & 7; f32x4 v[4]; float ss = 0.f;
#pragma unroll
          for (int q4 = 0; q4 < 4; ++q4) { v[q4] = *(const LAS f32x4*)(Os + t * 132 + part * 16 + 4 * q4); ss += (v[q4][0] * v[q4][0] + v[q4][1] * v[q4][1]) + (v[q4][2] * v[q4][2] + v[q4][3] * v[q4][3]); }
          ss += __shfl_xor(ss, 1); ss += __shfl_xor(ss, 2); ss += __shfl_xor(ss, 4);
          const float rs = __builtin_amdgcn_rsqf(ss * (1.f / 128.f) + 1e-6f);
          const bf16_t* rrow = Urow0 + (size_t)t * OD_INP + 1024 + h * 128 + part * 16;
          const u32x4 r0 = *(const u32x4*)rrow, r1 = *(const u32x4*)(rrow + 8);
          u32x4 o0, o1;
#pragma unroll
          for (int p = 0; p < 4; ++p) { const int e0 = 2 * p, q4 = e0 >> 2, i0 = e0 & 3;
              const f32x4 gn = *(const f32x4*)(gnorm + part * 16 + 4 * q4);
              o0[p] = pk2(v[q4][i0] * rs * gn[i0] * silu(bflo(r0[p])), v[q4][i0 + 1] * rs * gn[i0 + 1] * silu(bfhi(r0[p])));
              const f32x4 gn2 = *(const f32x4*)(gnorm + part * 16 + 8 + 4 * q4);
              o1[p] = pk2(v[2 + q4][i0] * rs * gn2[i0] * silu(bflo(r1[p])), v[2 + q4][i0 + 1] * rs * gn2[i0 + 1] * silu(bfhi(r1[p]))); }
          bf16_t* mo = MIX + (tok0 + t) * DM + h * 128 + part * 16;
          *(u32x4*)mo = o0; *(u32x4*)(mo + 8) = o1; }
        __syncthreads();
    }
}

DI int crow(int r, int hi) { return (r & 3) + 8 * (r >> 2) + 4 * hi; }
DI void mla_attn_phase(LAS unsigned char* lds, const bf16_t* Qg, const bf16_t* Kg, const bf16_t* Vtg, bf16_t* MIX) {
    const int tid = opq_tid(), lane = tid & 63, w = __builtin_amdgcn_readfirstlane(tid >> 6), r32 = lane & 31, hf = lane >> 5;
    constexpr int KP = 104, VP = 72, SLOT = 32768, VOFF = 64 * KP * 2;
    unsigned poff[4], pstep[4]; bool pisk[4];
#pragma unroll
    for (int i = 0; i < 4; ++i) { const int j = w + 8 * i;
        if (j < 13) { const int p = 64 * j + lane, row = p / 13, c = p % 13; poff[i] = (unsigned)(row * 96 + (c < 12 ? 8 * c : 0)); pstep[i] = 64 * 96; pisk[i] = true; }
        else { const int p = 64 * (j < 31 ? j - 13 : 0) + lane, dv = p / 9, c = p % 9; poff[i] = (unsigned)(dv * SEQ + (c < 8 ? 8 * c : 0)); pstep[i] = 64; pisk[i] = false; } }
    for (int v = opq_bid(); v < 256; v += gridDim.x) {
        const int bh = v & 7, pi = v >> 3;
        const bf16_t* kbase = Kg + (size_t)bh * SEQ * 96; const bf16_t* vbase = Vtg + (size_t)bh * 128 * SEQ;
        for (int half = 0; half < 2; ++half) {
            const int qb = half ? 63 - pi : pi, q0 = qb * 256 + 32 * w, NT = 4 * (qb + 1);
#define MLA_DMA(t, slot) do { _Pragma("unroll") for (int i_ = 0; i_ < 4; ++i_) { const bf16_t* src_ = (pisk[i_] ? kbase : vbase) + poff[i_] + (size_t)(t) * pstep[i_]; \
        __builtin_amdgcn_global_load_lds((const unsigned*)src_, (LAS unsigned*)(lds + (slot) * SLOT + (w + 8 * i_) * 1024), 16, 0, 0); } } while (0)
            MLA_DMA(0, 0); MLA_DMA(1, 1);
            const bf16_t* qp = Qg + ((size_t)bh * SEQ + q0 + r32) * 96 + 8 * hf;
            bf16x8 qf[6];
#pragma unroll
            for (int ks = 0; ks < 6; ++ks) qf[ks] = *(const bf16x8*)(qp + 16 * ks);
            f32x16 o[4];
#pragma unroll
            for (int mt = 0; mt < 4; ++mt)
#pragma unroll
                for (int i = 0; i < 16; ++i) o[mt][i] = 0.f;
            float m_run = -1e30f, l_run = 0.f;
#define VFRAG(dst, kk_) do { _Pragma("unroll") for (int mt = 0; mt < 4; ++mt) dst[mt] = *(const LAS bf16x8*)(vb + (32 * mt + r32) * VP + 16 * (kk_) + 8 * hf); } while (0)
#define MLA_PV() do { \
        _Pragma("unroll") for (int mt = 0; mt < 4; ++mt) o[mt] = MFMA32(vfa[mt], pf[0], o[mt]); \
        VFRAG(vfa, 2); __builtin_amdgcn_sched_barrier(0); \
        _Pragma("unroll") for (int mt = 0; mt < 4; ++mt) o[mt] = MFMA32(vfb[mt], pf[1], o[mt]); \
        VFRAG(vfb, 3); __builtin_amdgcn_sched_barrier(0); \
        _Pragma("unroll") for (int mt = 0; mt < 4; ++mt) o[mt] = MFMA32(vfa[mt], pf[2], o[mt]); \
        _Pragma("unroll") for (int mt = 0; mt < 4; ++mt) o[mt] = MFMA32(vfb[mt], pf[3], o[mt]); } while (0)
            asm volatile("s_waitcnt vmcnt(4)" ::: "memory");
            __builtin_amdgcn_s_barrier(); asm volatile("" ::: "memory");
            int sl = 0;
            for (int kt = 0; kt < NT; ++kt) {
                const int sl2 = sl == 0 ? 2 : sl - 1;
                if (kt + 2 < NT) MLA_DMA(kt + 2, sl2);
                if (64 * kt <= q0 + 31) {
                    const LAS bf16_t* kb = (const LAS bf16_t*)(lds + sl * SLOT); const LAS bf16_t* vb = (const LAS bf16_t*)(lds + sl * SLOT + VOFF);
#define KFRAG(da, dc, ks_) do { da = *(const LAS bf16x8*)(kb + r32 * KP + 16 * (ks_) + 8 * hf); dc = *(const LAS bf16x8*)(kb + (32 + r32) * KP + 16 * (ks_) + 8 * hf); } while (0)
                    bf16x8 ka0, kc0_, ka1, kc1_;
                    KFRAG(ka0, kc0_, 0); KFRAG(ka1, kc1_, 1);
                    __builtin_amdgcn_sched_barrier(0);
                    f32x16 s0, s1;
#pragma unroll
                    for (int i = 0; i < 16; ++i) { s0[i] = 0.f; s1[i] = 0.f; }
                    s0 = MFMA32(ka0, qf[0], s0); s1 = MFMA32(kc0_, qf[0], s1); KFRAG(ka0, kc0_, 2); __builtin_amdgcn_sched_barrier(0);
                    s0 = MFMA32(ka1, qf[1], s0); s1 = MFMA32(kc1_, qf[1], s1); KFRAG(ka1, kc1_, 3); __builtin_amdgcn_sched_barrier(0);
                    s0 = MFMA32(ka0, qf[2], s0); s1 = MFMA32(kc0_, qf[2], s1); KFRAG(ka0, kc0_, 4); __builtin_amdgcn_sched_barrier(0);
                    s0 = MFMA32(ka1, qf[3], s0); s1 = MFMA32(kc1_, qf[3], s1); KFRAG(ka1, kc1_, 5); __builtin_amdgcn_sched_barrier(0);
                    s0 = MFMA32(ka0, qf[4], s0); s1 = MFMA32(kc0_, qf[4], s1); s0 = MFMA32(ka1, qf[5], s0); s1 = MFMA32(kc1_, qf[5], s1);
#undef KFRAG
                    bf16x8 vfa[4], vfb[4];
                    VFRAG(vfa, 0); VFRAG(vfb, 1);
                    __builtin_amdgcn_sched_barrier(0);
                    if (kt >= 4 * qb) { const int qpos = q0 + r32;
#pragma unroll
                        for (int i = 0; i < 16; ++i) { const int key0 = 64 * kt + crow(i, hf); if (key0 > qpos) s0[i] = -INFINITY; if (key0 + 32 > qpos) s1[i] = -INFINITY; } }
                    float mxa = fmaxf(s0[0], s1[0]), mxb = fmaxf(s0[1], s1[1]), mxc = fmaxf(s0[2], s1[2]), mxd = fmaxf(s0[3], s1[3]);
#pragma unroll
                    for (int i = 4; i < 16; i += 4) { mxa = fmaxf(mxa, fmaxf(s0[i], s1[i])); mxb = fmaxf(mxb, fmaxf(s0[i + 1], s1[i + 1])); mxc = fmaxf(mxc, fmaxf(s0[i + 2], s1[i + 2])); mxd = fmaxf(mxd, fmaxf(s0[i + 3], s1[i + 3])); }
                    float mx = fmaxf(fmaxf(mxa, mxb), fmaxf(mxc, mxd));
                    { const auto rr = __builtin_amdgcn_permlane32_swap(__float_as_uint(mx), __float_as_uint(mx), false, false); mx = fmaxf(__uint_as_float(rr[0]), __uint_as_float(rr[1])); }
                    const float m_new = fmaxf(m_run, mx), alpha = __builtin_amdgcn_exp2f(m_run - m_new); m_run = m_new;
                    float sum = 0.f;
#pragma unroll
                    for (int i = 0; i < 16; ++i) { s0[i] = __builtin_amdgcn_exp2f(s0[i] - m_new); s1[i] = __builtin_amdgcn_exp2f(s1[i] - m_new); sum += s0[i] + s1[i]; }
                    l_run = l_run * alpha + sum;
                    if (__any(alpha != 1.f)) {
#pragma unroll
                        for (int mt = 0; mt < 4; ++mt)
#pragma unroll
                            for (int i = 0; i < 16; ++i) o[mt][i] *= alpha; }
                    bf16x8 pf[4];
#pragma unroll
                    for (int sp = 0; sp < 2; ++sp) { u32x4 p0, p1;
#pragma unroll
                        for (int j = 0; j < 4; ++j) { p0[j] = pk2(s0[8 * sp + 2 * j], s0[8 * sp + 2 * j + 1]); p1[j] = pk2(s1[8 * sp + 2 * j], s1[8 * sp + 2 * j + 1]); }
                        pf[sp] = __builtin_bit_cast(bf16x8, p0); pf[2 + sp] = __builtin_bit_cast(bf16x8, p1); }
                    __builtin_amdgcn_sched_barrier(0);
                    MLA_PV();
                }
                if (kt + 2 < NT) asm volatile("s_waitcnt vmcnt(4) lgkmcnt(0)" ::: "memory"); else asm volatile("s_waitcnt vmcnt(0) lgkmcnt(0)" ::: "memory");
                __builtin_amdgcn_s_barrier(); asm volatile("" ::: "memory");
                sl = sl == 2 ? 0 : sl + 1;
            }
#undef MLA_PV
#undef VFRAG
#undef MLA_DMA
            l_run += __shfl_xor(l_run, 32);
            const float inv = __builtin_amdgcn_rcpf(l_run);
            bf16_t* orow = MIX + ((size_t)(bh >> 2) * SEQ + q0 + r32) * DM + 512 + (bh & 3) * 128 + 4 * hf;
#pragma unroll
            for (int mt = 0; mt < 4; ++mt)
#pragma unroll
                for (int a4 = 0; a4 < 4; ++a4) { u32x2 p; p.x = pk2(o[mt][4 * a4] * inv, o[mt][4 * a4 + 1] * inv); p.y = pk2(o[mt][4 * a4 + 2] * inv, o[mt][4 * a4 + 3] * inv);
                    *(u32x2*)(orow + 32 * mt + 8 * a4) = p; }
        }
    }
}

#define RLX_AGENT __ATOMIC_RELAXED, __HIP_MEMORY_SCOPE_AGENT
#define XB_TMO      128
#define XB_XCNT(j)  (256  + 64 * (j))
#define XB_XSUB(j)  (1280 + 64 * (j))
#define XB_XGEN(j)  (2304 + 64 * (j))
#define XB_TOP      3328
#define XB_TOPGEN   3392
#define XCD_BAR_WORDS 3456
#define XB_SPIN_CAP (1u << 18)

__device__ __forceinline__ unsigned xb_ld(unsigned* p)              { return __hip_atomic_load(p, __ATOMIC_RELAXED, __HIP_MEMORY_SCOPE_AGENT); }
__device__ __forceinline__ unsigned xb_add(unsigned* p, unsigned v) { return __hip_atomic_fetch_add(p, v, __ATOMIC_RELAXED, __HIP_MEMORY_SCOPE_AGENT); }
__device__ __forceinline__ unsigned xb_xcc_id() { return (unsigned)__builtin_amdgcn_s_getreg((3 << 11) | 20) & 0xFu; }
#define XB_SPIN(cond, bar) do { unsigned _sp = 0; while (cond) { __builtin_amdgcn_s_sleep(1); \
    if ((++_sp & 255u) == 0u) { if (xb_ld(&(bar)[XB_TMO])) break; if (_sp > XB_SPIN_CAP) { atomicAdd(&(bar)[XB_TMO], 1u); break; } } } } while (0)

struct XcdBarrier {
    unsigned* bar; unsigned x;
    volatile LAS unsigned* st;
};

__device__ __forceinline__ XcdBarrier xcd_barrier_post(unsigned* bar, volatile LAS unsigned* st) {
    XcdBarrier b; b.bar = bar; b.x = xb_xcc_id(); b.st = st;
    if (threadIdx.x == 0) (void)xb_add(&bar[XB_XCNT(b.x)], 1u);
    return b;
}
__device__ __forceinline__ void xcd_barrier_complete(unsigned* bar, unsigned x, unsigned& nloc, unsigned& nx) {
    const unsigned G = gridDim.x * gridDim.y * gridDim.z;
    unsigned sum, cnt, mine, sp = 0u;
    for (;;) {
        sum = 0u; cnt = 0u; mine = 0u;
#pragma unroll
        for (unsigned j = 0; j < 16; ++j) { const unsigned c = xb_ld(&bar[XB_XCNT(j)]); sum += c; cnt += (c > 0u) ? 1u : 0u; mine = (j == x) ? c : mine; }
        if (sum == G) break;
        __builtin_amdgcn_s_sleep(1);
        if ((++sp & 255u) == 0u) { if (xb_ld(&bar[XB_TMO])) break; if (sp > XB_SPIN_CAP) { atomicAdd(&bar[XB_TMO], 1u); break; } }
    }
    nloc = mine > 0u ? mine : 1u; nx = cnt > 0u ? cnt : 1u;
}

__device__ __forceinline__ void xcd_barrier(const XcdBarrier& b) {
    asm volatile("s_waitcnt vmcnt(0)" ::: "memory");
    __syncthreads();
    if (threadIdx.x == 0) {
        unsigned* bar = b.bar;
        __builtin_amdgcn_s_waitcnt(0);
        unsigned nloc = b.st[0], nx = b.st[1];
        if (nloc == 0u) { xcd_barrier_complete(bar, b.x, nloc, nx); b.st[0] = nloc; b.st[1] = nx; }
        const unsigned old = xb_add(&bar[XB_XSUB(b.x)], 1u);
        const unsigned gen = old / nloc;
        if (old + 1u == (gen + 1u) * nloc) {
            __builtin_amdgcn_fence(__ATOMIC_RELEASE, "agent");
            asm volatile("s_waitcnt vmcnt(0)" ::: "memory");
            const unsigned og = xb_add(&bar[XB_TOP], 1u);
            const unsigned tg = og / nx;
            if (og + 1u == (tg + 1u) * nx) xb_add(&bar[XB_TOPGEN], 1u);
            else XB_SPIN(xb_ld(&bar[XB_TOPGEN]) == tg, bar);
            __builtin_amdgcn_fence(__ATOMIC_ACQUIRE, "agent");
            xb_add(&bar[XB_XGEN(b.x)], 1u);
            asm volatile("s_waitcnt vmcnt(0)" ::: "memory");
        } else {
            XB_SPIN(xb_ld(&bar[XB_XGEN(b.x)]) == gen, bar);
            __builtin_amdgcn_fence(__ATOMIC_ACQUIRE, "agent");
            asm volatile("s_waitcnt vmcnt(0)" ::: "memory");
        }
    }
    __syncthreads();
}

__host__ __device__ inline bool phase_empty(int ph) { if (ph == 0) return false; const int L = (ph - 1) / 9, k = (ph - 1) % 9; if (k == 5) return true; if (k == 8) return L != 3; return (L % 2 == 0) && (k == 2 || k == 3); }
constexpr int NPHASE = 37;
#define RUNP(bit, ...) do { if (PHM & (bit)) { __VA_ARGS__; if (REP & (bit)) { __syncthreads(); __VA_ARGS__; } } } while (0)
#ifndef PHM
#define PHM 0xfff
#endif

__global__ void __launch_bounds__(512) mega_fwd(Args a) {
    extern __shared__ __attribute__((aligned(16))) unsigned char lds_raw[];
    LAS unsigned char* lds = (LAS unsigned char*)lds_raw;
    cg::grid_group grid = cg::this_grid();
    unsigned char* ws = a.ws;
    bf16_t* XB = (bf16_t*)(ws + OFF_XB); bf16_t* U = (bf16_t*)(ws + OFF_U); bf16_t* MIX = (bf16_t*)(ws + OFF_MIX); bf16_t* HB = (bf16_t*)(ws + OFF_H);
    bf16_t* Qg = (bf16_t*)(ws + OFF_Q); bf16_t* Kg = (bf16_t*)(ws + OFF_KF); bf16_t* Vtg = (bf16_t*)(ws + OFF_VT);
    float* GST = (float*)(ws + OFF_GST); float* DVEC = (float*)(ws + OFF_DVEC);
    const int G = gridDim.x;
    volatile LAS unsigned* misc = (volatile LAS unsigned*)(lds + LDS_MISC_OFF);
    if (threadIdx.x < 2) misc[threadIdx.x] = 0u;
    __syncthreads();
    XcdBarrier xbar = xcd_barrier_post((unsigned*)(ws + OFF_CTL), misc);
    for (int ph = a.ph_lo; ph < a.ph_hi; ++ph) {
        if (phase_empty(ph)) continue;
        if (ph == 0) { RUNP(1, prologue_phase(a, lds)); }
        else {
            const int L = (ph - 1) / 9, k = (ph - 1) % 9, i = L >> 1; const bool odd = L & 1;
            float* STATS = (float*)(ws + OFF_STATS); const float* C1 = (const float*)(ws + OFF_CV); const float* C2 = C1 + NFOLD;
            if (k == 0) {
                if (ph == 1) fold_reduce(a);
                const bf16_t* Wt = odd ? (const bf16_t*)(ws + OFF_WIN_OD) + (size_t)i * OD_INP * DM : (const bf16_t*)(ws + OFF_WIN_EV) + (size_t)i * EV_IN * DM;
                const int N = odd ? OD_INP : EV_IN;
                pg8::Gemm g{XB, Wt, MTOK, N, DM}; pg8::StaticOrder S; S.init(MTOK, N, G, opq_bid());
                pg8::LnFold f{nullptr, nullptr, nullptr, 0};
                if (L > 0) { f.st = STATS + (size_t)1 * MTOK * 8; f.c1 = C1 + fold_off(L - 1); f.c2 = C2 + fold_off(L - 1); f.on = 1; }
                pg8::EpiBf16 E{U, N, f};
                RUNP(2, pg8::gemm_phase<pg8::EpiBf16, pg8::StaticOrder, true, true>(lds, g, S, E));
            } else if (k == 1) {
                if (!odd) { RUNP(4, conv_phase(U, a.in[2] + (size_t)i * 3 * 512, MIX)); RUNP(8, swa_phase(lds, U, a.in[3] + i * 8, MIX)); }
                else { RUNP(16, mla_prep_phase(lds, U, (const bf16_t*)(ws + OFF_WUQ) + (size_t)i * 384 * 256, (const bf16_t*)(ws + OFF_WUKV) + (size_t)i * 768 * 128, Qg, Kg, Vtg));
                       RUNP(32, gla_local_phase(lds, U, a.in[6] + (size_t)i * 16 * 256, a.in[7] + i * 256, GST, DVEC)); }
            } else if (k == 2) {
                if (PHM & 64) { if (REP & 16384) gla_scan_phase(GST, DVEC, (float*)XB); gla_scan_phase(GST, DVEC, GST); }
                RUNP(128, mla_attn_phase(lds, Qg, Kg, Vtg, MIX));
            } else if (k == 3) {
                RUNP(256, gla_out_phase(lds, U, a.in[6] + (size_t)i * 16 * 256, a.in[7] + i * 256, a.in[8] + i * 128, GST, MIX));
            } else if (k == 4 || k == 7) {
                const bf16_t* A; const bf16_t* Wt; int K; pg8::EpiRes E{nullptr, (L == 3 && k == 7) ? a.out : nullptr, XB, nullptr, nullptr, nullptr, nullptr, DM, ALPHA};
                if (k == 4) { A = MIX; K = DM; Wt = (odd ? (const bf16_t*)(ws + OFF_WOUT_OD) : (const bf16_t*)(ws + OFF_WOUT_EV)) + (size_t)i * DM * DM;
                    if (L == 0) E.xin = a.in[0]; else { E.st_prev = STATS + (size_t)1 * MTOK * 8; E.gp = a.in[19] + (size_t)(L - 1) * DM; E.bp = a.in[20] + (size_t)(L - 1) * DM; }
                    E.st_out = STATS; }
                else { A = HB; K = DFF; Wt = (const bf16_t*)(ws + OFF_WDN) + (size_t)L * DM * DFF;
                    E.st_prev = STATS; E.gp = a.in[17] + (size_t)L * DM; E.bp = a.in[18] + (size_t)L * DM; E.st_out = STATS + (size_t)1 * MTOK * 8; }
                pg8::Gemm g{A, Wt, MTOK, DM, K}; pg8::StaticOrder S; S.init(MTOK, DM, G, opq_bid());
                if (PHM & 512) { pg8::gemm_phase<pg8::EpiRes, pg8::StaticOrder, true, true>(lds, g, S, E);
                    if (REP & 8192) { __syncthreads(); pg8::EpiRes E2 = E; E2.zf = nullptr; E2.zb = U; E2.st_out = (float*)(ws + 480 * MiB); pg8::gemm_phase<pg8::EpiRes, pg8::StaticOrder, true, true>(lds, g, S, E2); } }
            } else if (k == 8) {
                if (PHM & 1024) ln_phase(a.out, a.out, a.in[19] + (size_t)L * DM, a.in[20] + (size_t)L * DM, nullptr);
            } else {
                pg8::Gemm g{XB, (const bf16_t*)(ws + OFF_WGU) + (size_t)L * 2 * DFF * DM, MTOK, 2 * DFF, DM}; pg8::StaticOrder S; S.init(MTOK, 2 * DFF, G, opq_bid());
                pg8::LnFold f{STATS, C1 + fold_off(3 + L), C2 + fold_off(3 + L), 1};
                pg8::EpiSwiglu E{HB, DFF, f};
                RUNP(2048, pg8::gemm_phase<pg8::EpiSwiglu, pg8::StaticOrder, true, true>(lds, g, S, E));
            }
        }
        if (ph + 1 < a.ph_hi) { if (a.ph_lo < 0) grid.sync(); else xcd_barrier(xbar); if (REP & 32768) xcd_barrier(xbar); }
    }
}

extern "C" void kernel_launch(void* const* d_in, const int* in_sizes, int n_in, void* d_out, int out_size, void* d_ws, size_t ws_size, hipStream_t stream) {
    static int grid = 0;
    if (grid == 0) {
        if (n_in != 21 || out_size != MTOK * DM || ws_size < WS_NEED) { fprintf(stderr, "kernel_launch: unexpected shapes (n_in %d out %d ws %zu)\n", n_in, out_size, ws_size); grid = -1; return; }
        int dev = 0, cus = 0, per_cu = 0;
        hipGetDevice(&dev); hipDeviceGetAttribute(&cus, hipDeviceAttributeMultiprocessorCount, dev);
        hipFuncSetAttribute((const void*)mega_fwd, hipFuncAttributeMaxDynamicSharedMemorySize, LDS_BYTES);
        hipOccupancyMaxActiveBlocksPerMultiprocessor(&per_cu, (const void*)mega_fwd, 512, LDS_BYTES);
        if (per_cu < 1) { fprintf(stderr, "kernel_launch: occupancy query gave %d\n", per_cu); per_cu = 1; }
        grid = cus * per_cu;
        (void)hipGetLastError();
    }
    if (grid < 0) return;
    if (hipMemsetAsync((char*)d_ws + OFF_CTL, 0, CTL_BYTES, stream) != hipSuccess) { fprintf(stderr, "kernel_launch: memset failed\n"); return; }
    Args a{};
    for (int i = 0; i < 21; ++i) a.in[i] = (const float*)d_in[i];
    a.out = (float*)d_out; a.ws = (unsigned char*)d_ws;
#if ONE_LAUNCH
    a.ph_lo = 0; a.ph_hi = NPHASE;
    { void* args[] = {&a}; hipError_t e = hipLaunchCooperativeKernel((const void*)mega_fwd, dim3(grid), dim3(512), args, LDS_BYTES, stream);
      if (e != hipSuccess) fprintf(stderr, "cooperative launch failed: %s (grid %d)\n", hipGetErrorString(e), grid); }
#else
    for (int ph = 0; ph < NPHASE; ++ph) {
        if (phase_empty(ph)) continue;
        a.ph_lo = ph; a.ph_hi = ph + 1;
        void* args[] = {&a}; hipError_t e = hipLaunchCooperativeKernel((const void*)mega_fwd, dim3(grid), dim3(512), args, LDS_BYTES, stream);
        if (e != hipSuccess) { fprintf(stderr, "launch of phase %d failed: %s (grid %d)\n", ph, hipGetErrorString(e), grid); break; }
    }
#endif
}
```

```cpp
#include <hip/hip_runtime.h>
#include <hip/hip_cooperative_groups.h>
#include <cstdio>
#include <cstdint>
namespace cg = cooperative_groups;

#ifndef ONE_LAUNCH
#define ONE_LAUNCH 1
#endif

#ifndef REP
#define REP 0
#endif
#define LAS __attribute__((address_space(3)))
#define DI __device__ __forceinline__
typedef unsigned short bf16_t;
typedef short bf16x8 __attribute__((ext_vector_type(8)));
typedef short s16x4 __attribute__((ext_vector_type(4)));
typedef float f32x4 __attribute__((ext_vector_type(4)));
typedef float f32x16 __attribute__((ext_vector_type(16)));
typedef unsigned u32x4 __attribute__((ext_vector_type(4)));
typedef unsigned u32x2 __attribute__((ext_vector_type(2)));

__device__ __forceinline__ int opq_tid() { int t = threadIdx.x; asm volatile("" : "+v"(t)); return t; }
__device__ __forceinline__ int opq_bid() { int t = blockIdx.x; asm volatile("" : "+s"(t)); return t; }
namespace pg8 {
#define PG8_LAS __attribute__((address_space(3)))
constexpr int BM = 256, BK = 64, HALF = 128, HTB = HALF * BK * 2, STAGE_BYTES = 8 * HTB, NXCD = 8, WGM = 8;

__host__ __device__ __forceinline__ int lds_byte(int r, int c) { const int st = (r >> 4) * 2 + (c >> 5), rr = r & 15, cc = c & 31, ob = rr * 64 + cc * 2; return st * 1024 + (ob ^ (((ob >> 9) & 1) << 5)); }
__host__ __device__ __forceinline__ void stage_rc(int b, int& R, int& C) { const int st = b / 1024, sb = b % 1024, swz = sb ^ (((sb >> 9) & 1) << 5); R = (st >> 1) * 16 + swz / 64; C = (st & 1) * 32 + (swz % 64) / 2; }
__host__ __device__ __forceinline__ int perm32(int rho) { const int n = rho >> 4, i = rho & 15; return 8 * (i >> 2) + 4 * n + (i & 3); }

struct Unit { int pm, pn; };
struct Gemm { const bf16_t* A; const bf16_t* Bt; int M, N, K; };

struct StaticOrder {
    int nM, nN, nwg, G, c;
    __host__ __device__ void init(int M, int N, int G_, int c_) { nM = M / BM; nN = N / BM; nwg = nM * nN; G = G_; c = c_; }
    __host__ __device__ bool next(int i, Unit& u) const {
        const long L = (long)i * G + c; if (L >= nwg) return false;
        int wgid = (int)L; { const int q = nwg / NXCD, r = nwg % NXCD, xcd = wgid % NXCD, off = wgid / NXCD; wgid = (xcd < r ? xcd * (q + 1) : r * (q + 1) + (xcd - r) * q) + off; }
        const int nig = WGM * nN, gid = wgid / nig, fm = gid * WGM, gsz = (nM - fm) < WGM ? (nM - fm) : WGM;
        u.pm = fm + ((wgid % nig) % gsz); u.pn = (wgid % nig) / gsz; return true;
    }
    __device__ __forceinline__ void a_ready(const Unit&) const {}
    __device__ __forceinline__ void done(const Unit&) const {}
};

__device__ __forceinline__ unsigned cvt_pk_bf16(float lo, float hi) { unsigned r; asm volatile("v_cvt_pk_bf16_f32 %0, %1, %2" : "=v"(r) : "v"(lo), "v"(hi)); return r; }

constexpr int XSLOT_OFF = STAGE_BYTES, XSLOT_BYTES = 10240, RED_OFF = XSLOT_OFF + 2 * XSLOT_BYTES;
struct LnFold { const float* st; const float* c1; const float* c2; int on; };
__device__ __forceinline__ void xslot_fetch(const float* st_rows, const float* v1, const float* v2, PG8_LAS unsigned char* slot, int tid, int wid) {
    __builtin_amdgcn_global_load_lds((const unsigned*)(st_rows + tid * 4), (PG8_LAS unsigned*)(slot + wid * 1024), 16, 0, 0);
    const float* vp = wid < 4 ? v1 + tid : v2 + (tid - 256);
    __builtin_amdgcn_global_load_lds((const unsigned*)vp, (PG8_LAS unsigned*)(slot + 8192 + wid * 256), 4, 0, 0);
}
__device__ __forceinline__ void ln_rows8(bool on, const PG8_LAS float* X, int rl0, float (&mean)[8], float (&rstd)[8]) {
#pragma unroll
    for (int i = 0; i < 8; ++i) { const int rl = rl0 + (i >> 2) * HALF + (i & 3) * 16; const f32x4 a = *(const PG8_LAS f32x4*)(X + 8 * rl), b = *(const PG8_LAS f32x4*)(X + 8 * rl + 4);
        const float s1 = on ? (a[0] + a[2]) + (b[0] + b[2]) : 0.f, s2 = on ? (a[1] + a[3]) + (b[1] + b[3]) : 1024.f;
        mean[i] = s1 * (1.f / 1024.f); const float var = s2 * (1.f / 1024.f) - mean[i] * mean[i]; rstd[i] = on ? __builtin_amdgcn_rsqf(fmaxf(var, 0.f) + 1e-5f) : 1.f; }
}
__device__ __forceinline__ void ln_row1(bool on, const PG8_LAS float* X, int rl, float& mean, float& rstd) {
    const f32x4 a = *(const PG8_LAS f32x4*)(X + 8 * rl), b = *(const PG8_LAS f32x4*)(X + 8 * rl + 4);
    const float s1 = on ? (a[0] + a[2]) + (b[0] + b[2]) : 0.f, s2 = on ? (a[1] + a[3]) + (b[1] + b[3]) : 1024.f;
    mean = s1 * (1.f / 1024.f); const float var = s2 * (1.f / 1024.f) - mean * mean; rstd = on ? __builtin_amdgcn_rsqf(fmaxf(var, 0.f) + 1e-5f) : 1.f;
}
struct NoPre {};
struct EpiBf16 {
    static constexpr bool PERM = true, AFTER_DRAIN = false;
    typedef NoPre Pre; __device__ __forceinline__ void preload(Pre&, const Unit&, int, int, int, int) const {}
    bf16_t* O; int ldc; LnFold f;
    __device__ __forceinline__ void prefetch(const Unit& u, PG8_LAS unsigned char* slot, int tid, int wid) const { if (f.on) xslot_fetch(f.st + 8 * (u.pm * BM), f.c1 + u.pn * BM, f.c2 + u.pn * BM, slot, tid, wid); }
    __device__ __forceinline__ void operator()(const f32x4 (&acc)[2][2][4][2], const Unit& u, int wr, int wc, int fr, int fq, const PG8_LAS float* X, PG8_LAS float* RED, const Pre&) const {
        const int row0 = u.pm * BM + wr * 64 + fr; const int cl0 = wc * 32 + 8 * fq, col0 = u.pn * BM + cl0; const bool on = f.on != 0;
        f32x4 c1v[2][2], c2v[2][2];
#pragma unroll
        for (int bj = 0; bj < 2; ++bj)
#pragma unroll
            for (int n = 0; n < 2; ++n) { const f32x4 a = *(const PG8_LAS f32x4*)(X + 2048 + cl0 + bj * HALF + 4 * n), b = *(const PG8_LAS f32x4*)(X + 2304 + cl0 + bj * HALF + 4 * n);
                c1v[bj][n] = on ? a : (f32x4){0.f, 0.f, 0.f, 0.f}; c2v[bj][n] = on ? b : (f32x4){0.f, 0.f, 0.f, 0.f}; }
        float mean8[8], rstd8[8]; ln_rows8(on, X, wr * 64 + fr, mean8, rstd8);
#pragma unroll
        for (int ai = 0; ai < 2; ++ai)
#pragma unroll
            for (int m = 0; m < 4; ++m) { const int row = row0 + ai * HALF + m * 16; bf16_t* rowp = O + (size_t)row * ldc + col0;
                const float mean = mean8[ai * 4 + m], rstd = rstd8[ai * 4 + m];
#pragma unroll
                for (int bj = 0; bj < 2; ++bj) { const f32x4 v0 = (acc[ai][bj][m][0] - c1v[bj][0] * mean) * rstd + c2v[bj][0], v1 = (acc[ai][bj][m][1] - c1v[bj][1] * mean) * rstd + c2v[bj][1];
                    u32x4 w; w.x = cvt_pk_bf16(v0[0], v0[1]); w.y = cvt_pk_bf16(v0[2], v0[3]); w.z = cvt_pk_bf16(v1[0], v1[1]); w.w = cvt_pk_bf16(v1[2], v1[3]);
                    *(u32x4*)(rowp + bj * HALF) = w; } }
    }
};
__device__ __forceinline__ float silu_f(float x) { return x * __builtin_amdgcn_rcpf(1.f + __builtin_amdgcn_exp2f(-x * 1.4426950408889634f)); }
struct EpiSwiglu {
    static constexpr bool PERM = true, AFTER_DRAIN = false;
    typedef NoPre Pre; __device__ __forceinline__ void preload(Pre&, const Unit&, int, int, int, int) const {}
    bf16_t* H; int ldc; LnFold f;
    __device__ __forceinline__ void prefetch(const Unit& u, PG8_LAS unsigned char* slot, int tid, int wid) const { xslot_fetch(f.st + 8 * (u.pm * BM), f.c1 + u.pn * BM, f.c2 + u.pn * BM, slot, tid, wid); }
    __device__ __forceinline__ void operator()(const f32x4 (&acc)[2][2][4][2], const Unit& u, int wr, int wc, int fr, int fq, const PG8_LAS float* X, PG8_LAS float* RED, const Pre&) const {
        const int row0 = u.pm * BM + wr * 64 + fr; const int cl0 = wc * 32 + 8 * fq, col0 = u.pn * HALF + cl0;
        f32x4 c1v[2][2], c2v[2][2];
#pragma unroll
        for (int bj = 0; bj < 2; ++bj)
#pragma unroll
            for (int n = 0; n < 2; ++n) { c1v[bj][n] = *(const PG8_LAS f32x4*)(X + 2048 + cl0 + bj * HALF + 4 * n); c2v[bj][n] = *(const PG8_LAS f32x4*)(X + 2304 + cl0 + bj * HALF + 4 * n); }
        float mean8[8], rstd8[8]; ln_rows8(true, X, wr * 64 + fr, mean8, rstd8);
#pragma unroll
        for (int ai = 0; ai < 2; ++ai)
#pragma unroll
            for (int m = 0; m < 4; ++m) { const int row = row0 + ai * HALF + m * 16; bf16_t* rowp = H + (size_t)row * ldc + col0;
                const float mean = mean8[ai * 4 + m], rstd = rstd8[ai * 4 + m];
                const f32x4 g0 = (acc[ai][0][m][0] - c1v[0][0] * mean) * rstd + c2v[0][0], g1 = (acc[ai][0][m][1] - c1v[0][1] * mean) * rstd + c2v[0][1];
                const f32x4 u0 = (acc[ai][1][m][0] - c1v[1][0] * mean) * rstd + c2v[1][0], u1 = (acc[ai][1][m][1] - c1v[1][1] * mean) * rstd + c2v[1][1];
                u32x4 w; w.x = cvt_pk_bf16(silu_f(g0[0]) * u0[0], silu_f(g0[1]) * u0[1]); w.y = cvt_pk_bf16(silu_f(g0[2]) * u0[2], silu_f(g0[3]) * u0[3]);
                w.z = cvt_pk_bf16(silu_f(g1[0]) * u1[0], silu_f(g1[1]) * u1[1]); w.w = cvt_pk_bf16(silu_f(g1[2]) * u1[2], silu_f(g1[3]) * u1[3]);
                *(u32x4*)rowp = w; }
    }
};
struct EpiRes {
    static constexpr bool PERM = true, AFTER_DRAIN = false;
    const float* xin; float* zf; bf16_t* zb; const float* st_prev; const float* gp; const float* bp; float* st_out; int ldc; float alpha;
    __device__ __forceinline__ void prefetch(const Unit& u, PG8_LAS unsigned char* slot, int tid, int wid) const { if (st_prev) xslot_fetch(st_prev + 8 * (u.pm * BM), gp + u.pn * BM, bp + u.pn * BM, slot, tid, wid); }
    struct Pre { u32x4 a, b; };
    __device__ __forceinline__ void preload(Pre& p, const Unit& u, int wr, int wc, int fr, int fq) const {
        if (!xin) { asm volatile("" : "+v"(fr), "+v"(fq)); const size_t o = (size_t)(u.pm * BM + wr * 64 + fr) * ldc + u.pn * BM + wc * 32 + 8 * fq; p.a = *(const u32x4*)(zb + o); p.b = *(const u32x4*)(zb + o + HALF); }
    }
    static __device__ __forceinline__ void unpack8(const u32x4 w, f32x4& lo, f32x4& hi) {
        lo[0] = __builtin_bit_cast(float, w.x << 16); lo[1] = __builtin_bit_cast(float, w.x & 0xffff0000u); lo[2] = __builtin_bit_cast(float, w.y << 16); lo[3] = __builtin_bit_cast(float, w.y & 0xffff0000u);
        hi[0] = __builtin_bit_cast(float, w.z << 16); hi[1] = __builtin_bit_cast(float, w.z & 0xffff0000u); hi[2] = __builtin_bit_cast(float, w.w << 16); hi[3] = __builtin_bit_cast(float, w.w & 0xffff0000u);
    }
    __device__ __forceinline__ void ldres8(size_t o, f32x4& lo, f32x4& hi) const {
        if (xin) { lo = *(const f32x4*)(xin + o); hi = *(const f32x4*)(xin + o + 4); return; }
        const u32x4 w = *(const u32x4*)(zb + o);
        lo[0] = __builtin_bit_cast(float, w.x << 16); lo[1] = __builtin_bit_cast(float, w.x & 0xffff0000u); lo[2] = __builtin_bit_cast(float, w.y << 16); lo[3] = __builtin_bit_cast(float, w.y & 0xffff0000u);
        hi[0] = __builtin_bit_cast(float, w.z << 16); hi[1] = __builtin_bit_cast(float, w.z & 0xffff0000u); hi[2] = __builtin_bit_cast(float, w.w << 16); hi[3] = __builtin_bit_cast(float, w.w & 0xffff0000u);
    }
    __device__ __forceinline__ void operator()(const f32x4 (&acc)[2][2][4][2], const Unit& u, int wr, int wc, int fr, int fq, const PG8_LAS float* X, PG8_LAS float* RED, const Pre& pre) const {
        typedef float f32x2v __attribute__((ext_vector_type(2)));
        asm volatile("" : "+v"(fr), "+v"(fq));
        const int rl0 = wr * 64 + fr, row0 = u.pm * BM + rl0; const int cl0 = wc * 32 + 8 * fq, col0 = u.pn * BM + cl0; const bool on = st_prev != nullptr;
        u32x4 rw[2];
        if (!xin) { rw[0] = pre.a; rw[1] = pre.b; }
#pragma unroll
        for (int i = 0; i < 8; ++i) { const int ai = i >> 2, m = i & 3; const int rl = rl0 + ai * HALF + m * 16; const size_t off = (size_t)(u.pm * BM + rl) * ldc + col0;
            f32x4 r[2][2];
            if (xin) {
#pragma unroll
                for (int bj = 0; bj < 2; ++bj) { r[bj][0] = *(const f32x4*)(xin + off + bj * HALF); r[bj][1] = *(const f32x4*)(xin + off + bj * HALF + 4); }
            } else {
#pragma unroll
                for (int bj = 0; bj < 2; ++bj) unpack8(rw[bj], r[bj][0], r[bj][1]);
                if (i < 7) { const size_t offn = (size_t)(row0 + ((i + 1) >> 2) * HALF + ((i + 1) & 3) * 16) * ldc + col0;
#pragma unroll
                    for (int bj = 0; bj < 2; ++bj) rw[bj] = *(const u32x4*)(zb + offn + bj * HALF); } }
            float mean, rstd; ln_row1(on, X, rl, mean, rstd);
            float s1 = 0.f, s2 = 0.f;
#pragma unroll
            for (int bj = 0; bj < 2; ++bj) { f32x4 z[2];
#pragma unroll
                for (int n = 0; n < 2; ++n) { const int cq = bj * HALF + 4 * n;
                    const f32x4 ga = *(const PG8_LAS f32x4*)(X + 2048 + cl0 + cq), ba = *(const PG8_LAS f32x4*)(X + 2304 + cl0 + cq);
                    const f32x4 x = on ? (r[bj][n] - mean) * rstd * ga + ba : r[bj][n];
                    z[n] = x * alpha + acc[ai][bj][m][n];
                    s1 += (z[n][0] + z[n][1]) + (z[n][2] + z[n][3]); s2 += (z[n][0] * z[n][0] + z[n][1] * z[n][1]) + (z[n][2] * z[n][2] + z[n][3] * z[n][3]); }
                const size_t o = off + bj * HALF;
                if (zf) { *(f32x4*)(zf + o) = z[0]; *(f32x4*)(zf + o + 4) = z[1]; }
                u32x4 w; w.x = cvt_pk_bf16(z[0][0], z[0][1]); w.y = cvt_pk_bf16(z[0][2], z[0][3]); w.z = cvt_pk_bf16(z[1][0], z[1][1]); w.w = cvt_pk_bf16(z[1][2], z[1][3]); if (!zf) *(u32x4*)(zb + o) = w; }
            s1 += __shfl_xor(s1, 16); s1 += __shfl_xor(s1, 32); s2 += __shfl_xor(s2, 16); s2 += __shfl_xor(s2, 32);
            if (fq == 0) *(PG8_LAS f32x2v*)(RED + (rl * 4 + wc) * 2) = (f32x2v){s1, s2};
            __builtin_amdgcn_sched_barrier(0); }
        asm volatile("s_waitcnt lgkmcnt(0)" ::: "memory"); __builtin_amdgcn_s_barrier(); asm volatile("" ::: "memory");
        { const int t = (wr * 4 + wc) * 64 + fq * 16 + fr;
          if (t < BM) { const f32x4 a = *(const PG8_LAS f32x4*)(RED + t * 8), b = *(const PG8_LAS f32x4*)(RED + t * 8 + 4);
              *(f32x2v*)(st_out + ((size_t)(u.pm * BM + t) * 4 + u.pn) * 2) = (f32x2v){(a[0] + a[2]) + (b[0] + b[2]), (a[1] + a[3]) + (b[1] + b[3])}; } }
    }
};

template <class Epi, class Sched, bool ALIGN_EPI = false, bool SP2 = false>
__device__ __forceinline__ void gemm_phase(PG8_LAS unsigned char* lds, const Gemm g, const Sched& S, const Epi& E) {
    const int tid = opq_tid(), wid = __builtin_amdgcn_readfirstlane(tid >> 6), lane = tid & 63, wr = wid >> 2, wc = wid & 3, fr = lane & 15, fq = lane >> 4;
    const int K = g.K, nt = K / BK;
    unsigned voffA[2], voffB[2];
#pragma unroll
    for (int i = 0; i < 2; ++i) { int R, C; stage_rc(tid * 16 + i * 8192, R, C); const int Rb = Epi::PERM ? ((R & ~31) + perm32(R & 31)) : R;
        voffA[i] = (unsigned)(R * K + C) * 2u; voffB[i] = (unsigned)(Rb * K + C) * 2u; }
    const size_t kstep = (size_t)(BK * 2);
    const size_t hstep = (size_t)HALF * K * 2;
    const size_t tstep = 2 * hstep;
    const unsigned ldsw = (unsigned)wid * 1024u;
    const int aoff = lds_byte(wr * 64 + fr, fq * 8), boff = lds_byte(wc * 32 + fr, fq * 8);
#define PG8_SA(b, h) (((b) * 2 + (h)) * HTB)
#define PG8_SB(b, h) ((4 + (b) * 2 + (h)) * HTB)
#define PG8_STAGE(bufoff, gbase, voff) do { _Pragma("unroll") for (int _i = 0; _i < 2; ++_i) \
        __builtin_amdgcn_global_load_lds((const unsigned*)((const char*)(gbase) + (voff)[_i]), (PG8_LAS unsigned*)(lds + (bufoff) + ldsw + _i * 8192), 16, 0, 0); } while (0)
#define PG8_LDA(dst, b, h) do { _Pragma("unroll") for (int m = 0; m < 4; ++m) _Pragma("unroll") for (int k = 0; k < 2; ++k) dst[m][k] = *(const PG8_LAS bf16x8*)(lds + PG8_SA(b, h) + aoff + m * 2048 + k * 1024); } while (0)
#define PG8_LDB(dst, b, h) do { _Pragma("unroll") for (int n = 0; n < 2; ++n) _Pragma("unroll") for (int k = 0; k < 2; ++k) dst[n][k] = *(const PG8_LAS bf16x8*)(lds + PG8_SB(b, h) + boff + n * 2048 + k * 1024); } while (0)
#define PG8_MMA(ai, bj, At, Bt) do { __builtin_amdgcn_s_setprio(1); _Pragma("unroll") for (int m = 0; m < 4; ++m) _Pragma("unroll") for (int n = 0; n < 2; ++n) _Pragma("unroll") for (int k = 0; k < 2; ++k) \
        acc[ai][bj][m][n] = __builtin_amdgcn_mfma_f32_16x16x32_bf16(Bt[n][k], At[m][k], acc[ai][bj][m][n], 0, 0, 0); __builtin_amdgcn_s_setprio(0); } while (0)
#define PG8_WAIT_V(n) asm volatile("s_waitcnt vmcnt(" #n ")" ::: "memory")
#define PG8_WAIT_L(n) asm volatile("s_waitcnt lgkmcnt(" #n ")" ::: "memory")
#define PG8_BAR __builtin_amdgcn_s_barrier()
#define PG8_SCHED __builtin_amdgcn_sched_barrier(0)
    Unit cur, nxt; int ui = 0;
    if (!S.next(0, cur)) return;
    f32x4 acc[2][2][4][2];
#pragma unroll
    for (int a = 0; a < 2; ++a)
#pragma unroll
        for (int b = 0; b < 2; ++b)
#pragma unroll
            for (int m = 0; m < 4; ++m)
#pragma unroll
                for (int n = 0; n < 2; ++n) acc[a][b][m][n] = (f32x4){0.f, 0.f, 0.f, 0.f};
    bf16x8 At[4][2], B0[2][2], B1[2][2];
    typename Epi::Pre pre;
    const char* cA = (const char*)g.A + (size_t)cur.pm * tstep; const char* cB = (const char*)g.Bt + (size_t)cur.pn * tstep;
    S.a_ready(cur);
    E.prefetch(cur, lds + XSLOT_OFF, tid, wid);
    if constexpr (SP2) {
        PG8_STAGE(PG8_SB(0, 0), cB, voffB); PG8_STAGE(PG8_SB(0, 1), cB + hstep, voffB); PG8_STAGE(PG8_SA(0, 0), cA, voffA); PG8_STAGE(PG8_SA(0, 1), cA + hstep, voffA);
        if (wr == 1) PG8_BAR;
        PG8_WAIT_V(2); PG8_BAR;
        PG8_STAGE(PG8_SB(1, 0), cB + kstep, voffB); PG8_STAGE(PG8_SA(1, 0), cA + kstep, voffA); PG8_STAGE(PG8_SB(1, 1), cB + hstep + kstep, voffB);
        PG8_WAIT_V(6); PG8_BAR;
    } else {
        PG8_STAGE(PG8_SB(0, 0), cB, voffB); PG8_STAGE(PG8_SA(0, 0), cA, voffA); PG8_STAGE(PG8_SB(0, 1), cB + hstep, voffB); PG8_STAGE(PG8_SA(0, 1), cA + hstep, voffA);
        if (wr == 1) PG8_BAR;
        PG8_WAIT_V(4); PG8_BAR;
        PG8_STAGE(PG8_SB(1, 0), cB + kstep, voffB); PG8_STAGE(PG8_SA(1, 0), cA + kstep, voffA); PG8_STAGE(PG8_SB(1, 1), cB + hstep + kstep, voffB);
        PG8_WAIT_V(6); PG8_BAR;
    }
    for (;;) {
        const bool has_next = S.next(ui + 1, nxt);
        const char* nA = has_next ? (const char*)g.A + (size_t)nxt.pm * tstep : cA; const char* nB = has_next ? (const char*)g.Bt + (size_t)nxt.pn * tstep : cB;
        for (int t = 0; t < nt; t += 2) {
            const bool last = (t == nt - 2);
            const char* a1 = cA + (size_t)(t + 1) * kstep;
            const char* a2 = last ? nA : cA + (size_t)(t + 2) * kstep; const char* b2 = last ? nB : cB + (size_t)(t + 2) * kstep;
            const char* a3 = a2 + kstep; const char* b3 = b2 + kstep;
            if (last) E.preload(pre, cur, wr, wc, fr, fq);
            if (last && has_next) { S.a_ready(nxt); E.prefetch(nxt, lds + XSLOT_OFF + ((ui + 1) & 1) * XSLOT_BYTES, tid, wid); }
            if constexpr (SP2) {
            PG8_LDB(B0, 0, 0); PG8_LDB(B1, 0, 1); PG8_SCHED; PG8_LDA(At, 0, 0); PG8_STAGE(PG8_SA(1, 1), a1 + hstep, voffA);
            PG8_WAIT_V(8); PG8_WAIT_L(0); PG8_BAR; PG8_MMA(0, 0, At, B0); PG8_MMA(0, 1, At, B1); PG8_BAR; PG8_SCHED;
            PG8_LDA(At, 0, 1); PG8_STAGE(PG8_SB(0, 0), b2, voffB); PG8_STAGE(PG8_SB(0, 1), b2 + hstep, voffB); PG8_STAGE(PG8_SA(0, 0), a2, voffA);
            PG8_WAIT_V(8); PG8_WAIT_L(0); PG8_BAR; PG8_MMA(1, 0, At, B0); PG8_MMA(1, 1, At, B1); PG8_BAR; PG8_SCHED;
            PG8_LDB(B0, 1, 0); PG8_LDB(B1, 1, 1); PG8_SCHED; PG8_LDA(At, 1, 0); PG8_STAGE(PG8_SA(0, 1), a2 + hstep, voffA);
            PG8_WAIT_V(8); PG8_WAIT_L(0); PG8_BAR; PG8_MMA(0, 0, At, B0); PG8_MMA(0, 1, At, B1); PG8_BAR; PG8_SCHED;
            PG8_LDA(At, 1, 1); PG8_STAGE(PG8_SB(1, 0), b3, voffB); PG8_STAGE(PG8_SB(1, 1), b3 + hstep, voffB); PG8_STAGE(PG8_SA(1, 0), a3, voffA);
            PG8_WAIT_V(8); PG8_WAIT_L(0); PG8_BAR; PG8_MMA(1, 0, At, B0); PG8_MMA(1, 1, At, B1); PG8_BAR; PG8_SCHED;
            } else {
            PG8_LDB(B0, 0, 0); PG8_SCHED; PG8_LDA(At, 0, 0); PG8_STAGE(PG8_SA(1, 1), a1 + hstep, voffA);
            PG8_WAIT_L(8); PG8_BAR; PG8_WAIT_L(0); PG8_MMA(0, 0, At, B0); PG8_BAR; PG8_SCHED;
            PG8_LDB(B1, 0, 1); PG8_STAGE(PG8_SB(0, 0), b2, voffB);
            PG8_BAR; PG8_WAIT_L(0); PG8_MMA(0, 1, At, B1); PG8_BAR;
            PG8_LDA(At, 0, 1); PG8_STAGE(PG8_SA(0, 0), a2, voffA);
            PG8_BAR; PG8_WAIT_L(0); PG8_MMA(1, 0, At, B0); PG8_BAR; PG8_SCHED;
            PG8_STAGE(PG8_SB(0, 1), b2 + hstep, voffB);
            PG8_WAIT_V(6); PG8_BAR; PG8_MMA(1, 1, At, B1); PG8_BAR;
            PG8_LDB(B0, 1, 0); PG8_SCHED; PG8_LDA(At, 1, 0); PG8_STAGE(PG8_SA(0, 1), a2 + hstep, voffA);
            PG8_WAIT_L(8); PG8_BAR; PG8_WAIT_L(0); PG8_MMA(0, 0, At, B0); PG8_BAR; PG8_SCHED;
            PG8_LDB(B1, 1, 1); PG8_STAGE(PG8_SB(1, 0), b3, voffB);
            PG8_BAR; PG8_WAIT_L(0); PG8_MMA(0, 1, At, B1); PG8_BAR;
            PG8_LDA(At, 1, 1); PG8_STAGE(PG8_SA(1, 0), a3, voffA);
            PG8_BAR; PG8_WAIT_L(0); PG8_MMA(1, 0, At, B0); PG8_BAR; PG8_SCHED;
            PG8_STAGE(PG8_SB(1, 1), b3 + hstep, voffB);
            PG8_WAIT_V(6); PG8_BAR; PG8_MMA(1, 1, At, B1); PG8_BAR;
            }
        }
        if constexpr (ALIGN_EPI) { if (wr == 0) PG8_BAR; }
        if constexpr (!Epi::AFTER_DRAIN) { E(acc, cur, wr, wc, fr, fq, (const PG8_LAS float*)(lds + XSLOT_OFF + (ui & 1) * XSLOT_BYTES), (PG8_LAS float*)(lds + RED_OFF), pre); S.done(cur); }
        if (!has_next) break;
#pragma unroll
        for (int a = 0; a < 2; ++a)
#pragma unroll
            for (int b = 0; b < 2; ++b)
#pragma unroll
                for (int m = 0; m < 4; ++m)
#pragma unroll
                    for (int n = 0; n < 2; ++n) acc[a][b][m][n] = (f32x4){0.f, 0.f, 0.f, 0.f};
        cur = nxt; cA = nA; cB = nB; ++ui;
        if constexpr (ALIGN_EPI) { if (wr == 1) PG8_BAR; }
    }
    PG8_WAIT_V(0);
    if constexpr (!ALIGN_EPI) { if (wr == 0) PG8_BAR; }
    PG8_BAR;
#undef PG8_SA
#undef PG8_SB
#undef PG8_STAGE
#undef PG8_LDA
#undef PG8_LDB
#undef PG8_MMA
#undef PG8_WAIT_V
#undef PG8_WAIT_L
#undef PG8_BAR
#undef PG8_SCHED
}
}

constexpr int SEQ = 16384, MTOK = 32768, DM = 1024, DFF = 2816;
constexpr int EV_IN = 2304, OD_INP = 2048;
constexpr float ALPHA = 1.681792830507429f;
constexpr float LOG2E = 1.4426950408889634f;
constexpr size_t MiB = 1u << 20;
constexpr size_t OFF_WIN_EV = 0;
constexpr size_t OFF_WOUT_EV = OFF_WIN_EV + (size_t)2 * EV_IN * DM * 2;
constexpr size_t OFF_WIN_OD = OFF_WOUT_EV + (size_t)2 * DM * DM * 2;
constexpr size_t OFF_WOUT_OD = OFF_WIN_OD + (size_t)2 * OD_INP * DM * 2;
constexpr size_t OFF_WGU = OFF_WOUT_OD + (size_t)2 * DM * DM * 2;
constexpr size_t OFF_WDN = OFF_WGU + (size_t)4 * 2 * DFF * DM * 2;
constexpr size_t OFF_WUQ = OFF_WDN + (size_t)4 * DM * DFF * 2;
constexpr size_t OFF_WUKV = OFF_WUQ + (size_t)2 * 384 * 256 * 2;
constexpr size_t OFF_WEND = OFF_WUKV + (size_t)2 * 768 * 128 * 2;
static_assert(OFF_WEND <= 92 * MiB, "weights");
constexpr size_t OFF_XB = 92 * MiB;
constexpr size_t OFF_U = 156 * MiB;
constexpr size_t OFF_MIX = 300 * MiB;
constexpr size_t OFF_Q = 364 * MiB;
constexpr size_t OFF_KF = 388 * MiB;
constexpr size_t OFF_VT = 412 * MiB;
constexpr size_t OFF_GST = 444 * MiB;
constexpr size_t OFF_DVEC = 508 * MiB;
constexpr size_t OFF_H = 300 * MiB;
constexpr size_t OFF_CV = 509 * MiB;
constexpr size_t OFF_STATS = OFF_CV + 512 * 1024;
constexpr size_t OFF_PART = 300 * MiB;
constexpr int NFOLD = 2048 + 2304 + 2048 + 4 * 5632;
constexpr size_t OFF_CTL = 511 * MiB + 512 * 1024;
constexpr size_t CTL_BYTES = 16384;
constexpr size_t WS_NEED = 512 * MiB;
static_assert(OFF_STATS + (size_t)2 * 32768 * 8 * 4 <= OFF_CTL && (size_t)2 * NFOLD * 4 <= 512 * 1024, "ws map");
constexpr int LDS_BYTES = 160 * 1024;
constexpr int LDS_MISC_OFF = pg8::RED_OFF + 8192;

struct Args { const float* in[21]; float* out; unsigned char* ws; int ph_lo, ph_hi; };

typedef float f32x2_t __attribute__((ext_vector_type(2))); typedef __bf16 bf16x2_t __attribute__((ext_vector_type(2)));
DI unsigned short f2bf(float f) { const __bf16 b = (__bf16)f; return __builtin_bit_cast(unsigned short, b); }
DI float bf2f(unsigned short h) { return __builtin_bit_cast(float, (unsigned)h << 16); }
DI unsigned pk2(float lo, float hi) { const f32x2_t v = {lo, hi}; const bf16x2_t b = __builtin_convertvector(v, bf16x2_t); return __builtin_bit_cast(unsigned, b); }
DI float bflo(unsigned w) { return __builtin_bit_cast(float, w << 16); }
DI float bfhi(unsigned w) { return __builtin_bit_cast(float, w & 0xffff0000u); }
#define MFMA16(a, b, c) __builtin_amdgcn_mfma_f32_16x16x32_bf16((a), (b), (c), 0, 0, 0)
#define MFMA32(a, b, c) __builtin_amdgcn_mfma_f32_32x32x16_bf16((a), (b), (c), 0, 0, 0)
DI float fexp(float x) { return __builtin_amdgcn_exp2f(x * LOG2E); }
DI float silu(float x) { return x * __builtin_amdgcn_rcpf(1.f + __builtin_amdgcn_exp2f(-x * LOG2E)); }

DI int wt_map(int mode, int n) {
    if (mode == 1) return n < 1024 ? n : (n < 1040 ? 1952 + (n - 1024) : n - 16);
    if (mode == 2) return (n >> 7) * 256 + (n & 127);
    if (mode == 3) return (n >> 7) * 256 + 128 + (n & 127);
    return n;
}
DI void transpose_item(const float* W, int K, int N, bf16_t* WT, int mode, const float* gk, const float* bk, float* p1, float* p2, LAS float* scr, int item, int lane) {
    const int nblk = (N + 31) / 32, kb = item / nblk, nb = item % nblk, k0 = 64 * kb, n0 = 32 * nb;
    const int n = n0 + (lane & 31);
    float v[32];
#pragma unroll
    for (int i = 0; i < 32; ++i) { const int kk = 2 * i + (lane >> 5); v[i] = (n < N) ? W[(size_t)(k0 + kk) * N + n] : 0.f; }
#pragma unroll
    for (int i = 0; i < 32; ++i) { const int kk = 2 * i + (lane >> 5); scr[kk * 33 + (lane & 31)] = v[i]; }
    asm volatile("s_waitcnt lgkmcnt(0)" ::: "memory");
    const int c = lane & 7;
    f32x4 g0 = (f32x4){1.f, 1.f, 1.f, 1.f}, g1 = g0, b0 = (f32x4){0.f, 0.f, 0.f, 0.f}, b1 = b0;
    if (gk) { g0 = *(const f32x4*)(gk + k0 + 8 * c); g1 = *(const f32x4*)(gk + k0 + 8 * c + 4); }
    if (bk) { b0 = *(const f32x4*)(bk + k0 + 8 * c); b1 = *(const f32x4*)(bk + k0 + 8 * c + 4); }
#pragma unroll
    for (int j = 0; j < 4; ++j) { const int nn = (lane >> 3) + 8 * j; const LAS float* sp = scr + (8 * c) * 33 + nn;
        float w[8];
#pragma unroll
        for (int e = 0; e < 8; ++e) w[e] = sp[e * 33];
        u32x4 o; o.x = pk2(w[0] * g0[0], w[1] * g0[1]); o.y = pk2(w[2] * g0[2], w[3] * g0[3]); o.z = pk2(w[4] * g1[0], w[5] * g1[1]); o.w = pk2(w[6] * g1[2], w[7] * g1[3]);
        const bool ok = n0 + nn < N; const int dr = wt_map(mode, n0 + nn);
        if (ok) *(u32x4*)(WT + (size_t)dr * K + k0 + 8 * c) = o;
        if (p1) { float a1 = ((bflo(o.x) + bfhi(o.x)) + (bflo(o.y) + bfhi(o.y))) + ((bflo(o.z) + bfhi(o.z)) + (bflo(o.w) + bfhi(o.w)));
            float a2 = ((w[0] * b0[0] + w[1] * b0[1]) + (w[2] * b0[2] + w[3] * b0[3])) + ((w[4] * b1[0] + w[5] * b1[1]) + (w[6] * b1[2] + w[7] * b1[3]));
            a1 += __shfl_xor(a1, 1); a1 += __shfl_xor(a1, 2); a1 += __shfl_xor(a1, 4); a2 += __shfl_xor(a2, 1); a2 += __shfl_xor(a2, 2); a2 += __shfl_xor(a2, 4);
            if (c == 0 && ok) { p1[(size_t)kb * NFOLD + dr] = a1; p2[(size_t)kb * NFOLD + dr] = a2; } } }
    asm volatile("s_waitcnt lgkmcnt(0)" ::: "memory");
}
DI int fold_off(int fm) { return fm == 0 ? 0 : fm == 1 ? 2048 : fm == 2 ? 4352 : 6400 + (fm - 3) * 5632; }
DI void prologue_phase(const Args& a, LAS unsigned char* lds) {
    const int tid = opq_tid(), lane = tid & 63, w = tid >> 6;
    LAS float* scr = (LAS float*)(lds + w * 8704);
    const int gw = opq_bid() * 8 + w, NGW = gridDim.x * 8;
    unsigned char* ws = a.ws;
    float* P1 = (float*)(ws + OFF_PART); float* P2 = P1 + (size_t)16 * NFOLD;
    int base = 0;
    for (int mat = 0; mat < 24; ++mat) {
        const float* W; int K, N, mode = 0; bf16_t* WT; const float* gk = nullptr; const float* bk = nullptr; int fm = -1;
        if (mat < 2)       { const int i = mat;      W = a.in[1] + (size_t)i * DM * EV_IN;  K = DM; N = EV_IN; WT = (bf16_t*)(ws + OFF_WIN_EV) + (size_t)i * EV_IN * DM; if (i == 1) { fm = 1; gk = a.in[19] + 1 * DM; bk = a.in[20] + 1 * DM; } }
        else if (mat < 4)  { const int i = mat - 2;  W = a.in[4] + (size_t)i * DM * DM;     K = DM; N = DM;    WT = (bf16_t*)(ws + OFF_WOUT_EV) + (size_t)i * DM * DM; }
        else if (mat < 6)  { const int i = mat - 4;  W = a.in[5] + (size_t)i * DM * 1968;   K = DM; N = 1968;  WT = (bf16_t*)(ws + OFF_WIN_OD) + (size_t)i * OD_INP * DM; mode = 1; fm = i ? 2 : 0; gk = a.in[19] + (size_t)(2 * i) * DM; bk = a.in[20] + (size_t)(2 * i) * DM; }
        else if (mat < 8)  { const int i = mat - 6;  W = a.in[13] + (size_t)i * DM * DM;    K = DM; N = DM;    WT = (bf16_t*)(ws + OFF_WOUT_OD) + (size_t)i * DM * DM; }
        else if (mat < 12) { const int l = mat - 8;  W = a.in[14] + (size_t)l * DM * DFF;   K = DM; N = DFF;   WT = (bf16_t*)(ws + OFF_WGU) + (size_t)l * 2 * DFF * DM; mode = 2; fm = 3 + l; gk = a.in[17] + (size_t)l * DM; bk = a.in[18] + (size_t)l * DM; }
        else if (mat < 16) { const int l = mat - 12; W = a.in[15] + (size_t)l * DM * DFF;   K = DM; N = DFF;   WT = (bf16_t*)(ws + OFF_WGU) + (size_t)l * 2 * DFF * DM; mode = 3; fm = 3 + l; gk = a.in[17] + (size_t)l * DM; bk = a.in[18] + (size_t)l * DM; }
        else if (mat < 20) { const int l = mat - 16; W = a.in[16] + (size_t)l * DFF * DM;   K = DFF; N = DM;   WT = (bf16_t*)(ws + OFF_WDN) + (size_t)l * DM * DFF; }
        else if (mat < 22) { const int i = mat - 20; W = a.in[10] + (size_t)i * 256 * 384;  K = 256; N = 384;  WT = (bf16_t*)(ws + OFF_WUQ) + (size_t)i * 384 * 256; gk = a.in[9] + i * 256; }
        else               { const int i = mat - 22; W = a.in[12] + (size_t)i * 128 * 768;  K = 128; N = 768;  WT = (bf16_t*)(ws + OFF_WUKV) + (size_t)i * 768 * 128; gk = a.in[11] + i * 128; }
        float* p1 = fm >= 0 ? P1 + fold_off(fm) : nullptr; float* p2 = fm >= 0 ? P2 + fold_off(fm) : nullptr;
        const int nitems = (K / 64) * ((N + 31) / 32);
        int it = gw - (base % NGW); if (it < 0) it += NGW;
        for (; it < nitems; it += NGW) transpose_item(W, K, N, WT, mode, gk, bk, p1, p2, scr, it, lane);
        base += nitems;
    }
    { const int gt = opq_bid() * 512 + tid, NT = gridDim.x * 512;
      for (int e = gt; e < 2 * 80 * 128; e += NT) { const int i = e / (80 * 128), r = (e / 128) % 80, c = e % 128;
          unsigned oz_ = 0u; asm volatile("" : "+v"(oz_));
          *(u32x4*)((bf16_t*)(ws + OFF_WIN_OD) + ((size_t)i * OD_INP + 1968 + r) * DM + 8 * c) = (u32x4){oz_, oz_, oz_, oz_}; }
      const float* x = a.in[0]; bf16_t* xb = (bf16_t*)(ws + OFF_XB);
      for (size_t e = gt; e < (size_t)MTOK * DM / 8; e += (size_t)4 * NT) {
          f32x4 v0[4], v1[4];
#pragma unroll
          for (int j = 0; j < 4; ++j) { const size_t ee = e + (size_t)j * NT; if (ee < (size_t)MTOK * DM / 8) { v0[j] = *(const f32x4*)(x + ee * 8); v1[j] = *(const f32x4*)(x + ee * 8 + 4); } }
#pragma unroll
          for (int j = 0; j < 4; ++j) { const size_t ee = e + (size_t)j * NT; if (ee < (size_t)MTOK * DM / 8) {
              u32x4 o; o.x = pk2(v0[j][0], v0[j][1]); o.y = pk2(v0[j][2], v0[j][3]); o.z = pk2(v1[j][0], v1[j][1]); o.w = pk2(v1[j][2], v1[j][3]); *(u32x4*)(xb + ee * 8) = o; } } } }
}
DI void fold_reduce(const Args& a) {
    const int gt = opq_bid() * 512 + opq_tid(), NT = gridDim.x * 512;
    const float* P1 = (const float*)(a.ws + OFF_PART); const float* P2 = P1 + (size_t)16 * NFOLD;
    float* C1 = (float*)(a.ws + OFF_CV); float* C2 = C1 + NFOLD;
    for (int n = gt; n < NFOLD; n += NT) {
        const bool pad = (n >= 1968 && n < 2048) || (n >= 4352 + 1968 && n < 4352 + 2048);
        float s1 = 0.f, s2 = 0.f;
        if (!pad) {
#pragma unroll
            for (int kb = 0; kb < 16; ++kb) { s1 += P1[(size_t)kb * NFOLD + n]; s2 += P2[(size_t)kb * NFOLD + n]; } }
        C1[n] = s1; C2[n] = s2;
    }
}

DI float wave_sum(float v) {
#pragma unroll
    for (int o = 1; o < 64; o <<= 1) v += __shfl_xor(v, o);
    return v;
}
DI void ln_phase(const float* Xin, float* X, const float* g, const float* b, bf16_t* XB) {
    const int tid = opq_tid(), lane = tid & 63, w = tid >> 6;
    const int gw = opq_bid() * 8 + w, NGW = gridDim.x * 8;
    f32x4 gv[4], bv[4];
#pragma unroll
    for (int j = 0; j < 4; ++j) { gv[j] = *(const f32x4*)(g + lane * 4 + 256 * j); bv[j] = *(const f32x4*)(b + lane * 4 + 256 * j); }
    f32x4 vn[4];
    if (gw < MTOK) {
#pragma unroll
        for (int j = 0; j < 4; ++j) vn[j] = *(const f32x4*)(Xin + (size_t)gw * DM + lane * 4 + 256 * j); }
    for (int m = gw; m < MTOK; m += NGW) {
        float* xr = X + (size_t)m * DM + lane * 4;
        f32x4 v[4]; float s = 0.f;
#pragma unroll
        for (int j = 0; j < 4; ++j) { v[j] = vn[j]; s += (v[j][0] + v[j][1]) + (v[j][2] + v[j][3]); }
        if (m + NGW < MTOK) {
#pragma unroll
            for (int j = 0; j < 4; ++j) vn[j] = *(const f32x4*)(Xin + (size_t)(m + NGW) * DM + lane * 4 + 256 * j); }
        const float mean = wave_sum(s) * (1.f / DM); float s2 = 0.f;
#pragma unroll
        for (int j = 0; j < 4; ++j) { v[j] = v[j] - mean; s2 += (v[j][0] * v[j][0] + v[j][1] * v[j][1]) + (v[j][2] * v[j][2] + v[j][3] * v[j][3]); }
        const float rstd = __builtin_amdgcn_rsqf(wave_sum(s2) * (1.f / DM) + 1e-5f);
#pragma unroll
        for (int j = 0; j < 4; ++j) { const f32x4 o = v[j] * rstd * gv[j] + bv[j]; *(f32x4*)(xr + 256 * j) = o;
            if (XB) { u32x2 p; p.x = pk2(o[0], o[1]); p.y = pk2(o[2], o[3]); *(u32x2*)(XB + (size_t)m * DM + lane * 4 + 256 * j) = p; } }
    }
}

DI void conv_phase(const bf16_t* U, const float* cw  , bf16_t* MIX) {
    const int gt = opq_bid() * 512 + opq_tid(), NT = gridDim.x * 512;
    for (int id = gt; id < MTOK * 64; id += NT) {
        const int t = id >> 6, c8 = (id & 63) * 8, tl = t & (SEQ - 1);
        const bf16_t* row = U + (size_t)t * EV_IN;
        float acc[8];
#pragma unroll
        for (int e = 0; e < 8; ++e) acc[e] = 0.f;
#pragma unroll
        for (int j = 0; j < 3; ++j) {
            if (tl - 2 + j >= 0) {
                const bf16_t* r2 = row - (size_t)(2 - j) * EV_IN;
                const u32x4 cg = *(const u32x4*)(r2 + 512 + c8), hh = *(const u32x4*)(r2 + 1024 + c8);
                const f32x4 w0 = *(const f32x4*)(cw + j * 512 + c8), w1 = *(const f32x4*)(cw + j * 512 + c8 + 4);
#pragma unroll
                for (int p = 0; p < 4; ++p) { const float wl = p < 2 ? w0[2 * p] : w1[2 * p - 4], wh = p < 2 ? w0[2 * p + 1] : w1[2 * p - 3];
                    acc[2 * p] += wl * (bflo(cg[p]) * bflo(hh[p])); acc[2 * p + 1] += wh * (bfhi(cg[p]) * bfhi(hh[p])); }
            }
        }
        const u32x4 bg = *(const u32x4*)(row + c8);
        u32x4 o;
#pragma unroll
        for (int p = 0; p < 4; ++p) o[p] = pk2(bflo(bg[p]) * acc[2 * p], bfhi(bg[p]) * acc[2 * p + 1]);
        *(u32x4*)(MIX + (size_t)t * DM + c8) = o;
    }
}
DI void swa_phase(LAS unsigned char* lds, const bf16_t* U, const float* sinks, bf16_t* MIX) {
    const int tid = opq_tid(), lane = tid & 63, w = tid >> 6, l16 = lane & 15, g = lane >> 4;
    constexpr int KP = 72, VP = 280;
    LAS bf16_t* Ks = (LAS bf16_t*)lds;
    LAS bf16_t* Vt = (LAS bf16_t*)(lds + 256 * KP * 2);
    for (int unit = opq_bid(); unit < 512; unit += gridDim.x) {
        const int hk = unit & 1, n = (unit >> 1) & 127, b = unit >> 8;
        const long tok0 = (long)b * SEQ + (long)n * 128;
#pragma unroll 1
        for (int i = 0; i < 4; ++i) { const int id = tid + 512 * i, kk = id >> 3, c = id & 7;
            u32x4 kv = (u32x4){0u, 0u, 0u, 0u}, vv = (u32x4){0u, 0u, 0u, 0u};
            if (n > 0 || kk >= 128) { const bf16_t* row = U + (size_t)(tok0 - 128 + kk) * EV_IN; kv = *(const u32x4*)(row + 2048 + hk * 64 + 8 * c); vv = *(const u32x4*)(row + 2176 + hk * 64 + 8 * c); }
            *(LAS u32x4*)(Ks + kk * KP + 8 * c) = kv;
#pragma unroll
            for (int e = 0; e < 8; ++e) Vt[(8 * c + e) * VP + kk] = (bf16_t)(vv[e >> 1] >> (16 * (e & 1)));
        }
#pragma unroll
        for (int i = 0; i < 2; ++i) { const int id = tid + 512 * i; Vt[(id >> 4) * VP + 256 + (id & 15)] = 0; }
        __syncthreads();
#pragma unroll 1
        for (int gi = 0; gi < 4; ++gi) {
            const int hq = hk * 4 + gi;
            const long qtok = tok0 + 16 * w + l16;
            const bf16_t* qrow = U + (size_t)qtok * EV_IN + 1536 + hq * 64 + 8 * g;
            const bf16x8 q0 = *(const bf16x8*)qrow, q1 = *(const bf16x8*)(qrow + 32);
            f32x4 s[10];
#pragma unroll
            for (int i = 0; i < 9; ++i) { const LAS bf16_t* kp = Ks + (16 * (w + i) + l16) * KP + 8 * g;
                const bf16x8 k0 = *(const LAS bf16x8*)kp, k1 = *(const LAS bf16x8*)(kp + 32);
                f32x4 acc = (f32x4){0.f, 0.f, 0.f, 0.f}; acc = MFMA16(k0, q0, acc); acc = MFMA16(k1, q1, acc); s[i] = acc; if ((i % 3) == 2) __builtin_amdgcn_sched_barrier(0); }
            s[9] = (f32x4){0.f, 0.f, 0.f, 0.f};
            const int qi = 16 * w + l16; const float sc = 0.125f * LOG2E, sink2 = sinks[hq] * LOG2E;
            float mx = -INFINITY;
#pragma unroll
            for (int i = 0; i < 9; ++i)
#pragma unroll
                for (int r = 0; r < 4; ++r) { const int kk = 16 * (w + i) + 4 * g + r; const bool ok = (kk > qi) && (kk <= qi + 128) && (n > 0 || kk >= 128);
                    const float v = ok ? s[i][r] * sc : -INFINITY; s[i][r] = v; mx = fmaxf(mx, v); }
            mx = fmaxf(mx, __shfl_xor(mx, 16)); mx = fmaxf(mx, __shfl_xor(mx, 32));
            const float m = fmaxf(mx, sink2); float sum = 0.f;
#pragma unroll
            for (int i = 0; i < 9; ++i)
#pragma unroll
                for (int r = 0; r < 4; ++r) { const float p = __builtin_amdgcn_exp2f(s[i][r] - m); s[i][r] = p; sum += p; }
            sum += __shfl_xor(sum, 16); sum += __shfl_xor(sum, 32);
            const float inv = __builtin_amdgcn_rcpf(sum + __builtin_amdgcn_exp2f(sink2 - m));
            f32x4 o[4];
#pragma unroll
            for (int mt = 0; mt < 4; ++mt) o[mt] = (f32x4){0.f, 0.f, 0.f, 0.f};
#pragma unroll
            for (int ks = 0; ks < 5; ++ks) {
                u32x4 pw; pw.x = pk2(s[2 * ks][0], s[2 * ks][1]); pw.y = pk2(s[2 * ks][2], s[2 * ks][3]); pw.z = pk2(s[2 * ks + 1][0], s[2 * ks + 1][1]); pw.w = pk2(s[2 * ks + 1][2], s[2 * ks + 1][3]);
                const bf16x8 pb = __builtin_bit_cast(bf16x8, pw);
#pragma unroll
                for (int mt = 0; mt < 4; ++mt) { const LAS bf16_t* vp = Vt + (16 * mt + l16) * VP + 16 * (w + 2 * ks) + 4 * g;
                    const s16x4 lo = *(const LAS s16x4*)vp, hi = *(const LAS s16x4*)(vp + 16);
                    const bf16x8 va = __builtin_shufflevector(lo, hi, 0, 1, 2, 3, 4, 5, 6, 7);
                    o[mt] = MFMA16(va, pb, o[mt]); }
                __builtin_amdgcn_sched_barrier(0);
            }
            bf16_t* orow = MIX + (size_t)qtok * DM + 512 + hq * 64 + 4 * g;
#pragma unroll
            for (int mt = 0; mt < 4; ++mt) { u32x2 p; p.x = pk2(o[mt][0] * inv, o[mt][1] * inv); p.y = pk2(o[mt][2] * inv, o[mt][3] * inv); *(u32x2*)(orow + 16 * mt) = p; }
        }
        __syncthreads();
    }
}

DI void rope_cs(int pos, int i, float& c, float& s) {
    const float invf = __builtin_amdgcn_exp2f(-(float)i * 0.8304820237218406f);
    const float ang = (float)pos * invf;
    const float k = __builtin_rintf(ang * 0.15915494309189535f);
    float r = fmaf(-k, 6.28125f, ang); r = fmaf(-k, 0.0019353071795864769f, r);
    const float fr = r * 0.15915494309189535f;
    s = __builtin_amdgcn_sinf(fr); c = __builtin_amdgcn_cosf(fr);
}
DI void mla_prep_phase(LAS unsigned char* lds, const bf16_t* U, const bf16_t* Wuq, const bf16_t* Wukv, bf16_t* Qg, bf16_t* Kg, bf16_t* Vtg) {
    const int tid = opq_tid(), lane = tid & 63, w = tid >> 6, l16 = lane & 15, g = lane >> 4;
    constexpr int QP = 264, CP = 136;
    LAS bf16_t* Aq = (LAS bf16_t*)lds;
    LAS bf16_t* Akv = (LAS bf16_t*)(lds + 64 * QP * 2);
    LAS float* rq = (LAS float*)(lds + 64 * QP * 2 + 64 * CP * 2);
    LAS float* rkv = rq + 64;
    LAS bf16_t* Vst = (LAS bf16_t*)(lds + 64 * QP * 2 + 64 * CP * 2 + 512);
    const float QSCALE = 0.10206207261596577f * LOG2E;
    for (int unit = opq_bid(); unit < 512; unit += gridDim.x) {
        const int row0 = unit * 64, b = row0 >> 14, s0 = row0 & (SEQ - 1);
#pragma unroll
        for (int i = 0; i < 4; ++i) { const int id = tid + 512 * i, r = id >> 5, c = id & 31;
            *(LAS u32x4*)(Aq + r * QP + 8 * c) = *(const u32x4*)(U + (size_t)(row0 + r) * OD_INP + 1536 + 8 * c); }
#pragma unroll
        for (int i = 0; i < 2; ++i) { const int id = tid + 512 * i, r = id >> 4, c = id & 15;
            *(LAS u32x4*)(Akv + r * CP + 8 * c) = *(const u32x4*)(U + (size_t)(row0 + r) * OD_INP + 1792 + 8 * c); }
#pragma unroll
        for (int i = 0; i < 2; ++i) { const int id = tid + 512 * i, r = id >> 4, p = id & 15; const int pos = s0 + r;
            const bf16_t* kr = U + (size_t)(row0 + r) * OD_INP + 1920; const float t1 = bf2f(kr[p]), t2 = bf2f(kr[16 + p]);
            float c, s; rope_cs(pos, p, c, s); const bf16_t o1 = f2bf(t1 * c - t2 * s), o2 = f2bf(t2 * c + t1 * s);
#pragma unroll
            for (int hh = 0; hh < 4; ++hh) { bf16_t* kd = Kg + ((size_t)(b * 4 + hh) * SEQ + pos) * 96 + 64; kd[p] = o1; kd[16 + p] = o2; } }
        __syncthreads();
        { const int r = tid >> 3, part = tid & 7; float ss = 0.f;
#pragma unroll
          for (int e = 0; e < 32; ++e) { const float v = bf2f(Aq[r * QP + part * 32 + e]); ss += v * v; }
          ss += __shfl_xor(ss, 1); ss += __shfl_xor(ss, 2); ss += __shfl_xor(ss, 4);
          float s2 = 0.f;
#pragma unroll
          for (int e = 0; e < 16; ++e) { const float v = bf2f(Akv[r * CP + part * 16 + e]); s2 += v * v; }
          s2 += __shfl_xor(s2, 1); s2 += __shfl_xor(s2, 2); s2 += __shfl_xor(s2, 4);
          if (part == 0) { rq[r] = __builtin_amdgcn_rsqf(ss * (1.f / 256.f) + 1e-6f); rkv[r] = __builtin_amdgcn_rsqf(s2 * (1.f / 128.f) + 1e-6f); } }
        __syncthreads();
        const int hh = w & 3, nt0 = (w >> 2) * 2;
        {
            f32x4 acc[6][2];
#pragma unroll
            for (int mt = 0; mt < 6; ++mt) { acc[mt][0] = (f32x4){0.f, 0.f, 0.f, 0.f}; acc[mt][1] = (f32x4){0.f, 0.f, 0.f, 0.f}; }
#pragma unroll 4
            for (int ks = 0; ks < 8; ++ks) {
                bf16x8 bfr[2];
#pragma unroll
                for (int j = 0; j < 2; ++j) bfr[j] = *(const LAS bf16x8*)(Aq + (16 * (nt0 + j) + l16) * QP + 32 * ks + 8 * g);
#pragma unroll
                for (int mt = 0; mt < 6; ++mt) { const bf16x8 af = *(const bf16x8*)(Wuq + (size_t)(96 * hh + 16 * mt + l16) * 256 + 32 * ks + 8 * g);
                    acc[mt][0] = MFMA16(af, bfr[0], acc[mt][0]); acc[mt][1] = MFMA16(af, bfr[1], acc[mt][1]); }
            }
#pragma unroll
            for (int j = 0; j < 2; ++j) { const int tokl = 16 * (nt0 + j) + l16, pos = s0 + tokl; const float rs = rq[tokl] * QSCALE;
                bf16_t* qo = Qg + ((size_t)(b * 4 + hh) * SEQ + pos) * 96;
#pragma unroll
                for (int mt = 0; mt < 4; ++mt) { u32x2 p; p.x = pk2(acc[mt][j][0] * rs, acc[mt][j][1] * rs); p.y = pk2(acc[mt][j][2] * rs, acc[mt][j][3] * rs); *(u32x2*)(qo + 16 * mt + 4 * g) = p; }
                float o1[4], o2[4];
#pragma unroll
                for (int r = 0; r < 4; ++r) { float c, s; rope_cs(pos, 4 * g + r, c, s); const float t1 = acc[4][j][r] * rs, t2 = acc[5][j][r] * rs; o1[r] = t1 * c - t2 * s; o2[r] = t2 * c + t1 * s; }
                u32x2 p1, p2; p1.x = pk2(o1[0], o1[1]); p1.y = pk2(o1[2], o1[3]); p2.x = pk2(o2[0], o2[1]); p2.y = pk2(o2[2], o2[3]);
                *(u32x2*)(qo + 64 + 4 * g) = p1; *(u32x2*)(qo + 80 + 4 * g) = p2; }
        }
#pragma unroll 1
        for (int grp = 0; grp < 3; ++grp) {
            f32x4 acc[4][2];
#pragma unroll
            for (int mt = 0; mt < 4; ++mt) { acc[mt][0] = (f32x4){0.f, 0.f, 0.f, 0.f}; acc[mt][1] = (f32x4){0.f, 0.f, 0.f, 0.f}; }
#pragma unroll
            for (int ks = 0; ks < 4; ++ks) {
                bf16x8 bfr[2];
#pragma unroll
                for (int j = 0; j < 2; ++j) bfr[j] = *(const LAS bf16x8*)(Akv + (16 * (nt0 + j) + l16) * CP + 32 * ks + 8 * g);
#pragma unroll
                for (int mt = 0; mt < 4; ++mt) { const bf16x8 af = *(const bf16x8*)(Wukv + (size_t)(192 * hh + 64 * grp + 16 * mt + l16) * 128 + 32 * ks + 8 * g);
                    acc[mt][0] = MFMA16(af, bfr[0], acc[mt][0]); acc[mt][1] = MFMA16(af, bfr[1], acc[mt][1]); }
            }
#pragma unroll
            for (int j = 0; j < 2; ++j) { const int tokl = 16 * (nt0 + j) + l16, pos = s0 + tokl; const float rs = rkv[tokl];
                const int tokp = 16 * (nt0 + j) + 8 * ((l16 >> 2) & 1) + 4 * (l16 >> 3) + (l16 & 3);
                if (grp == 0) { bf16_t* ko = Kg + ((size_t)(b * 4 + hh) * SEQ + pos) * 96;
#pragma unroll
                    for (int mt = 0; mt < 4; ++mt) { u32x2 p; p.x = pk2(acc[mt][j][0] * rs, acc[mt][j][1] * rs); p.y = pk2(acc[mt][j][2] * rs, acc[mt][j][3] * rs); *(u32x2*)(ko + 16 * mt + 4 * g) = p; } }
                else {
#pragma unroll
                    for (int mt = 0; mt < 4; ++mt)
#pragma unroll
                        for (int r = 0; r < 4; ++r) { const int dv = 64 * (grp - 1) + 16 * mt + 4 * g + r; Vst[(hh * 128 + dv) * 72 + tokp] = f2bf(acc[mt][j][r] * rs); } } }
        }
        __syncthreads();
#pragma unroll
        for (int i = 0; i < 8; ++i) { const int id = tid + 512 * i, row = id >> 3, c = id & 7;
            *(u32x4*)(Vtg + ((size_t)(b * 4 + (row >> 7)) * 128 + (row & 127)) * SEQ + s0 + 8 * c) = *(const LAS u32x4*)(Vst + row * 72 + 8 * c); }
        __syncthreads();
    }
}

DI void gla_gates(const bf16_t* Urow0, const float* wg, const float* bg, int h, LAS float* tot, float (&bc)[8], float& total, int tid) {
    const int d = tid & 63, seg = tid >> 6, col = h * 64 + d;
    float wr[16];
#pragma unroll
    for (int r = 0; r < 16; ++r) wr[r] = wg[r * 256 + col];
    const float bias = bg[col]; float run = 0.f;
#pragma unroll
    for (int tt = 0; tt < 8; ++tt) { const bf16_t* gl = Urow0 + (size_t)(8 * seg + tt) * OD_INP + 1952;
        const u32x4 a0 = *(const u32x4*)gl, a1 = *(const u32x4*)(gl + 8); float z = bias;
#pragma unroll
        for (int p = 0; p < 4; ++p) { z += bflo(a0[p]) * wr[2 * p] + bfhi(a0[p]) * wr[2 * p + 1]; z += bflo(a1[p]) * wr[8 + 2 * p] + bfhi(a1[p]) * wr[9 + 2 * p]; }
        const float ls = -(fmaxf(-z, 0.f) + __builtin_amdgcn_logf(1.f + fexp(-fabsf(z))) * 0.6931471805599453f);
        run += ls * (1.f / 16.f); bc[tt] = run; }
    tot[seg * 64 + d] = run; __syncthreads();
    float prefix = 0.f; total = 0.f;
#pragma unroll
    for (int s = 0; s < 8; ++s) { const float v = tot[s * 64 + d]; total += v; if (s < seg) prefix += v; }
#pragma unroll
    for (int tt = 0; tt < 8; ++tt) bc[tt] += prefix;
}
DI void gla_vt_load(u32x4 (&vv)[2], const bf16_t* Urow0, int h, int tid) {
#pragma unroll
    for (int i = 0; i < 2; ++i) { const int id = tid + 512 * i, t = id & 63, c8 = id >> 6; vv[i] = *(const u32x4*)(Urow0 + (size_t)t * OD_INP + 512 + h * 128 + 8 * c8); }
}
DI void gla_vt_store(LAS bf16_t* Vt, const u32x4 (&vv)[2], int tid) {
#pragma unroll
    for (int i = 0; i < 2; ++i) { const int id = tid + 512 * i, t = id & 63, c8 = id >> 6;
#pragma unroll
        for (int e = 0; e < 8; ++e) Vt[(8 * c8 + e) * 72 + t] = (bf16_t)(vv[i][e >> 1] >> (16 * (e & 1))); }
}
DI void gla_local_phase(LAS unsigned char* lds, const bf16_t* U, const float* wg, const float* bg, float* GST, float* DVEC) {
    const int tid = opq_tid(), lane = tid & 63, w = tid >> 6, l16 = lane & 15, g = lane >> 4, d = tid & 63, seg = tid >> 6;
    LAS float* tot = (LAS float*)lds; LAS bf16_t* Kt = (LAS bf16_t*)(lds + 2048); LAS bf16_t* Vt = (LAS bf16_t*)(lds + 2048 + 9216);
    for (int unit = opq_bid(); unit < 2048; unit += gridDim.x) {
        const int c = unit & 255, bh = unit >> 8, b = bh >> 2, h = bh & 3;
        const bf16_t* Urow0 = U + ((size_t)b * SEQ + (size_t)c * 64) * OD_INP;
        u32x4 vv[2]; gla_vt_load(vv, Urow0, h, tid);
        bf16_t kraw[8];
#pragma unroll
        for (int tt = 0; tt < 8; ++tt) kraw[tt] = Urow0[(size_t)(8 * seg + tt) * OD_INP + 256 + h * 64 + d];
        float bc[8], total; gla_gates(Urow0, wg, bg, h, tot, bc, total, tid);
        float kd[8];
#pragma unroll
        for (int tt = 0; tt < 8; ++tt) kd[tt] = bf2f(kraw[tt]) * fexp(total - bc[tt]);
        u32x4 pk; pk.x = pk2(kd[0], kd[1]); pk.y = pk2(kd[2], kd[3]); pk.z = pk2(kd[4], kd[5]); pk.w = pk2(kd[6], kd[7]);
        *(LAS u32x4*)(Kt + d * 72 + 8 * seg) = pk;
        if (seg == 0) DVEC[(size_t)unit * 64 + d] = fexp(total);
        gla_vt_store(Vt, vv, tid);
        __syncthreads();
        const int mt = w & 3; f32x4 acc[4];
#pragma unroll
        for (int j = 0; j < 4; ++j) acc[j] = (f32x4){0.f, 0.f, 0.f, 0.f};
#pragma unroll
        for (int ks = 0; ks < 2; ++ks) { const bf16x8 af = *(const LAS bf16x8*)(Kt + (16 * mt + l16) * 72 + 32 * ks + 8 * g);
#pragma unroll
            for (int j = 0; j < 4; ++j) { const int nt = (w >> 2) * 4 + j; const bf16x8 bfr = *(const LAS bf16x8*)(Vt + (16 * nt + l16) * 72 + 32 * ks + 8 * g); acc[j] = MFMA16(bfr, af, acc[j]); } }
#pragma unroll
        for (int j = 0; j < 4; ++j) { const int nt = (w >> 2) * 4 + j; u32x2 pw; pw.x = pk2(acc[j][0], acc[j][1]); pw.y = pk2(acc[j][2], acc[j][3]);
            *(u32x2*)((bf16_t*)GST + ((size_t)unit * 64 + 16 * mt + l16) * 128 + 16 * nt + 4 * g) = pw; }
        __syncthreads();
    }
}
DI void gla_scan_phase(float* GST, const float* DVEC, float* GOUT) {
    const int tid = opq_tid();
    if (tid < 256) {
        for (int e = opq_bid() * 256 + tid; e < 65536; e += gridDim.x * 256) {
            const int bh = e >> 13, rem = e & 8191, dk = rem >> 7;
            const bf16_t* p = (const bf16_t*)GST + (size_t)bh * 256 * 8192 + rem; bf16_t* po = (bf16_t*)GOUT + (size_t)bh * 256 * 8192 + rem; const float* dv = DVEC + (size_t)bh * 256 * 64 + dk;
            float S = 0.f;
            for (int c = 0; c < 256; c += 16) { bf16_t t[16]; float dd[16];
#pragma unroll
                for (int j = 0; j < 16; ++j) { t[j] = p[(size_t)(c + j) * 8192]; dd[j] = dv[(c + j) * 64]; }
#pragma unroll
                for (int j = 0; j < 16; ++j) { po[(size_t)(c + j) * 8192] = f2bf(S); S = dd[j] * S + bf2f(t[j]); } }
        }
    }
}
DI void gla_out_phase(LAS unsigned char* lds, const bf16_t* U, const float* wg, const float* bg, const float* gnorm, const float* GST, bf16_t* MIX) {
    const int tid = opq_tid(), lane = tid & 63, w = tid >> 6, l16 = lane & 15, g = lane >> 4, d = tid & 63, seg = tid >> 6;
    LAS float* tot = (LAS float*)lds; LAS bf16_t* Qs = (LAS bf16_t*)(lds + 2048); LAS bf16_t* Ks = (LAS bf16_t*)(lds + 11264);
    LAS bf16_t* Vt = (LAS bf16_t*)(lds + 20480); LAS bf16_t* St = (LAS bf16_t*)(lds + 38912); LAS bf16_t* Ps = (LAS bf16_t*)(lds + 57344);
    LAS float* Os = (LAS float*)(lds + 66560);
    for (int unit = opq_bid(); unit < 2048; unit += gridDim.x) {
        const int c = unit & 255, bh = unit >> 8, b = bh >> 2, h = bh & 3;
        const size_t tok0 = (size_t)b * SEQ + (size_t)c * 64;
        const bf16_t* Urow0 = U + tok0 * OD_INP;
        u32x4 vv[2]; gla_vt_load(vv, Urow0, h, tid);
        bf16_t qraw[8], kraw[8]; u32x4 stv[2];
#pragma unroll
        for (int tt = 0; tt < 8; ++tt) { const bf16_t* row = Urow0 + (size_t)(8 * seg + tt) * OD_INP; qraw[tt] = row[h * 64 + d]; kraw[tt] = row[256 + h * 64 + d]; }
#pragma unroll
        for (int i = 0; i < 2; ++i) { const int id = tid + 512 * i, dk = id & 63, c8 = id >> 6; stv[i] = *(const u32x4*)((const bf16_t*)GST + ((size_t)unit * 64 + dk) * 128 + 8 * c8); }
        float bc[8], total; gla_gates(Urow0, wg, bg, h, tot, bc, total, tid);
#pragma unroll
        for (int tt = 0; tt < 8; ++tt) { const int t = 8 * seg + tt;
            Qs[t * 72 + d] = f2bf(bf2f(qraw[tt]) * 0.125f * fexp(bc[tt])); Ks[t * 72 + d] = f2bf(bf2f(kraw[tt]) * fexp(-bc[tt])); }
        gla_vt_store(Vt, vv, tid);
#pragma unroll
        for (int i = 0; i < 2; ++i) { const int id = tid + 512 * i, dk = id & 63, c8 = id >> 6;
#pragma unroll
            for (int e = 0; e < 8; ++e) St[(8 * c8 + e) * 72 + dk] = (bf16_t)(stv[i][e >> 1] >> (16 * (e & 1))); }
        __syncthreads();
        const int mt = w & 3;
#pragma unroll
        for (int j = 0; j < 2; ++j) { const int nt = (w >> 2) * 2 + j; f32x4 acc = (f32x4){0.f, 0.f, 0.f, 0.f};
#pragma unroll
            for (int ks = 0; ks < 2; ++ks) { const bf16x8 af = *(const LAS bf16x8*)(Qs + (16 * mt + l16) * 72 + 32 * ks + 8 * g), bfr = *(const LAS bf16x8*)(Ks + (16 * nt + l16) * 72 + 32 * ks + 8 * g); acc = MFMA16(af, bfr, acc); }
#pragma unroll
            for (int r = 0; r < 4; ++r) { const int t = 16 * mt + 4 * g + r, s = 16 * nt + l16; Ps[t * 72 + s] = f2bf(s <= t ? acc[r] : 0.f); } }
        __syncthreads();
        { f32x4 o[4];
#pragma unroll
          for (int j = 0; j < 4; ++j) o[j] = (f32x4){0.f, 0.f, 0.f, 0.f};
#pragma unroll
          for (int ks = 0; ks < 2; ++ks) { const bf16x8 aq = *(const LAS bf16x8*)(Qs + (16 * mt + l16) * 72 + 32 * ks + 8 * g), ap = *(const LAS bf16x8*)(Ps + (16 * mt + l16) * 72 + 32 * ks + 8 * g);
#pragma unroll
              for (int j = 0; j < 4; ++j) { const int nt = (w >> 2) * 4 + j; const bf16x8 bs = *(const LAS bf16x8*)(St + (16 * nt + l16) * 72 + 32 * ks + 8 * g), bv = *(const LAS bf16x8*)(Vt + (16 * nt + l16) * 72 + 32 * ks + 8 * g);
                  o[j] = MFMA16(aq, bs, o[j]); o[j] = MFMA16(ap, bv, o[j]); } }
#pragma unroll
          for (int j = 0; j < 4; ++j) { const int nt = (w >> 2) * 4 + j;
#pragma unroll
              for (int r = 0; r < 4; ++r) Os[(16 * mt + 4 * g + r) * 132 + 16 * nt + l16] = o[j][r]; } }
        __syncthreads();
        { const int t = tid >> 3, part = tid & 7; f32x4 v[4]; float ss = 0.f;
#pragma unroll
          for (int q4 = 0; q4 < 4; ++q4) { v[q4] = *(const LAS f32x4*)(Os + t * 132 + part * 16 + 4 * q4); ss += (v[q4][0] * v[q4][0] + v[q4][1] * v[q4][1]) + (v[q4][2] * v[q4][2] + v[q4][3] * v[q4][3]); }
          ss += __shfl_xor(ss, 1); ss += __shfl_xor(ss, 2); ss += __shfl_xor(ss, 4);
          const float rs = __builtin_amdgcn_rsqf(ss * (1.f / 128.f) + 1e-6f);
          const bf16_t* rrow = Urow0 + (size_t)t * OD_INP + 1024 + h * 128 + part * 16;
          const u32x4 r0 = *(const u32x4*)rrow, r1 = *(const u32x4*)(rrow + 8);
          u32x4 o0, o1;
#pragma unroll
          for (int p = 0; p < 4; ++p) { const int e0 = 2 * p, q4 = e0 >> 2, i0 = e0 & 3;
              const f32x4 gn = *(const f32x4*)(gnorm + part * 16 + 4 * q4);
              o0[p] = pk2(v[q4][i0] * rs * gn[i0] * silu(bflo(r0[p])), v[q4][i0 + 1] * rs * gn[i0 + 1] * silu(bfhi(r0[p])));
              const f32x4 gn2 = *(const f32x4*)(gnorm + part * 16 + 8 + 4 * q4);
              o1[p] = pk2(v[2 + q4][i0] * rs * gn2[i0] * silu(bflo(r1[p])), v[2 + q4][i0 + 1] * rs * gn2[i0 + 1] * silu(bfhi(r1[p]))); }
          bf16_t* mo = MIX + (tok0 + t) * DM + h * 128 + part * 16;
          *(u32x4*)mo = o0; *(u32x4*)(mo + 8) = o1; }
        __syncthreads();
    }
}

DI int crow(int r, int hi) { return (r & 3) + 8 * (r >> 2) + 4 * hi; }
DI void mla_attn_phase(LAS unsigned char* lds, const bf16_t* Qg, const bf16_t* Kg, const bf16_t* Vtg, bf16_t* MIX) {
    const int tid = opq_tid(), lane = tid & 63, w = __builtin_amdgcn_readfirstlane(tid >> 6), r32 = lane & 31, hf = lane >> 5;
    constexpr int KP = 104, VP = 72, SLOT = 32768, VOFF = 64 * KP * 2;
    unsigned poff[4], pstep[4]; bool pisk[4];
#pragma unroll
    for (int i = 0; i < 4; ++i) { const int j = w + 8 * i;
        if (j < 13) { const int p = 64 * j + lane, row = p / 13, c = p % 13; poff[i] = (unsigned)(row * 96 + (c < 12 ? 8 * c : 0)); pstep[i] = 64 * 96; pisk[i] = true; }
        else { const int p = 64 * (j < 31 ? j - 13 : 0) + lane, dv = p / 9, c = p % 9; poff[i] = (unsigned)(dv * SEQ + (c < 8 ? 8 * c : 0)); pstep[i] = 64; pisk[i] = false; } }
    for (int v = opq_bid(); v < 256; v += gridDim.x) {
        const int bh = v & 7, pi = v >> 3;
        const bf16_t* kbase = Kg + (size_t)bh * SEQ * 96; const bf16_t* vbase = Vtg + (size_t)bh * 128 * SEQ;
        for (int half = 0; half < 2; ++half) {
            const int qb = half ? 63 - pi : pi, q0 = qb * 256 + 32 * w, NT = 4 * (qb + 1);
#define MLA_DMA(t, slot) do { _Pragma("unroll") for (int i_ = 0; i_ < 4; ++i_) { const bf16_t* src_ = (pisk[i_] ? kbase : vbase) + poff[i_] + (size_t)(t) * pstep[i_]; \
        __builtin_amdgcn_global_load_lds((const unsigned*)src_, (LAS unsigned*)(lds + (slot) * SLOT + (w + 8 * i_) * 1024), 16, 0, 0); } } while (0)
            MLA_DMA(0, 0); MLA_DMA(1, 1);
            const bf16_t* qp = Qg + ((size_t)bh * SEQ + q0 + r32) * 96 + 8 * hf;
            bf16x8 qf[6];
#pragma unroll
            for (int ks = 0; ks < 6; ++ks) qf[ks] = *(const bf16x8*)(qp + 16 * ks);
            f32x16 o[4];
#pragma unroll
            for (int mt = 0; mt < 4; ++mt)
#pragma unroll
                for (int i = 0; i < 16; ++i) o[mt][i] = 0.f;
            float m_run = -1e30f, l_run = 0.f;
#define VFRAG(dst, kk_) do { _Pragma("unroll") for (int mt = 0; mt < 4; ++mt) dst[mt] = *(const LAS bf16x8*)(vb + (32 * mt + r32) * VP + 16 * (kk_) + 8 * hf); } while (0)
#define MLA_PV() do { \
        _Pragma("unroll") for (int mt = 0; mt < 4; ++mt) o[mt] = MFMA32(vfa[mt], pf[0], o[mt]); \
        VFRAG(vfa, 2); __builtin_amdgcn_sched_barrier(0); \
        _Pragma("unroll") for (int mt = 0; mt < 4; ++mt) o[mt] = MFMA32(vfb[mt], pf[1], o[mt]); \
        VFRAG(vfb, 3); __builtin_amdgcn_sched_barrier(0); \
        _Pragma("unroll") for (int mt = 0; mt < 4; ++mt) o[mt] = MFMA32(vfa[mt], pf[2], o[mt]); \
        _Pragma("unroll") for (int mt = 0; mt < 4; ++mt) o[mt] = MFMA32(vfb[mt], pf[3], o[mt]); } while (0)
            asm volatile("s_waitcnt vmcnt(4)" ::: "memory");
            __builtin_amdgcn_s_barrier(); asm volatile("" ::: "memory");
            int sl = 0;
            for (int kt = 0; kt < NT; ++kt) {
                const int sl2 = sl == 0 ? 2 : sl - 1;
                if (kt + 2 < NT) MLA_DMA(kt + 2, sl2);
                if (64 * kt <= q0 + 31) {
                    const LAS bf16_t* kb = (const LAS bf16_t*)(lds + sl * SLOT); const LAS bf16_t* vb = (const LAS bf16_t*)(lds + sl * SLOT + VOFF);
#define KFRAG(da, dc, ks_) do { da = *(const LAS bf16x8*)(kb + r32 * KP + 16 * (ks_) + 8 * hf); dc = *(const LAS bf16x8*)(kb + (32 + r32) * KP + 16 * (ks_) + 8 * hf); } while (0)
                    bf16x8 ka0, kc0_, ka1, kc1_;
                    KFRAG(ka0, kc0_, 0); KFRAG(ka1, kc1_, 1);
                    __builtin_amdgcn_sched_barrier(0);
                    f32x16 s0, s1;
#pragma unroll
                    for (int i = 0; i < 16; ++i) { s0[i] = 0.f; s1[i] = 0.f; }
                    s0 = MFMA32(ka0, qf[0], s0); s1 = MFMA32(kc0_, qf[0], s1); KFRAG(ka0, kc0_, 2); __builtin_amdgcn_sched_barrier(0);
                    s0 = MFMA32(ka1, qf[1], s0); s1 = MFMA32(kc1_, qf[1], s1); KFRAG(ka1, kc1_, 3); __builtin_amdgcn_sched_barrier(0);
                    s0 = MFMA32(ka0, qf[2], s0); s1 = MFMA32(kc0_, qf[2], s1); KFRAG(ka0, kc0_, 4); __builtin_amdgcn_sched_barrier(0);
                    s0 = MFMA32(ka1, qf[3], s0); s1 = MFMA32(kc1_, qf[3], s1); KFRAG(ka1, kc1_, 5); __builtin_amdgcn_sched_barrier(0);
                    s0 = MFMA32(ka0, qf[4], s0); s1 = MFMA32(kc0_, qf[4], s1); s0 = MFMA32(ka1, qf[5], s0); s1 = MFMA32(kc1_, qf[5], s1);
#undef KFRAG
                    bf16x8 vfa[4], vfb[4];
                    VFRAG(vfa, 0); VFRAG(vfb, 1);
                    __builtin_amdgcn_sched_barrier(0);
                    if (kt >= 4 * qb) { const int qpos = q0 + r32;
#pragma unroll
                        for (int i = 0; i < 16; ++i) { const int key0 = 64 * kt + crow(i, hf); if (key0 > qpos) s0[i] = -INFINITY; if (key0 + 32 > qpos) s1[i] = -INFINITY; } }
                    float mxa = fmaxf(s0[0], s1[0]), mxb = fmaxf(s0[1], s1[1]), mxc = fmaxf(s0[2], s1[2]), mxd = fmaxf(s0[3], s1[3]);
#pragma unroll
                    for (int i = 4; i < 16; i += 4) { mxa = fmaxf(mxa, fmaxf(s0[i], s1[i])); mxb = fmaxf(mxb, fmaxf(s0[i + 1], s1[i + 1])); mxc = fmaxf(mxc, fmaxf(s0[i + 2], s1[i + 2])); mxd = fmaxf(mxd, fmaxf(s0[i + 3], s1[i + 3])); }
                    float mx = fmaxf(fmaxf(mxa, mxb), fmaxf(mxc, mxd));
                    { const auto rr = __builtin_amdgcn_permlane32_swap(__float_as_uint(mx), __float_as_uint(mx), false, false); mx = fmaxf(__uint_as_float(rr[0]), __uint_as_float(rr[1])); }
                    const float m_new = fmaxf(m_run, mx), alpha = __builtin_amdgcn_exp2f(m_run - m_new); m_run = m_new;
                    float sum = 0.f;
#pragma unroll
                    for (int i = 0; i < 16; ++i) { s0[i] = __builtin_amdgcn_exp2f(s0[i] - m_new); s1[i] = __builtin_amdgcn_exp2f(s1[i] - m_new); sum += s0[i] + s1[i]; }
                    l_run = l_run * alpha + sum;
                    if (__any(alpha != 1.f)) {
#pragma unroll
                        for (int mt = 0; mt < 4; ++mt)
#pragma unroll
                            for (int i = 0; i < 16; ++i) o[mt][i] *= alpha; }
                    bf16x8 pf[4];
#pragma unroll
                    for (int sp = 0; sp < 2; ++sp) { u32x4 p0, p1;
#pragma unroll
                        for (int j = 0; j < 4; ++j) { p0[j] = pk2(s0[8 * sp + 2 * j], s0[8 * sp + 2 * j + 1]); p1[j] = pk2(s1[8 * sp + 2 * j], s1[8 * sp + 2 * j + 1]); }
                        pf[sp] = __builtin_bit_cast(bf16x8, p0); pf[2 + sp] = __builtin_bit_cast(bf16x8, p1); }
                    __builtin_amdgcn_sched_barrier(0);
                    MLA_PV();
                }
                if (kt + 2 < NT) asm volatile("s_waitcnt vmcnt(4) lgkmcnt(0)" ::: "memory"); else asm volatile("s_waitcnt vmcnt(0) lgkmcnt(0)" ::: "memory");
                __builtin_amdgcn_s_barrier(); asm volatile("" ::: "memory");
                sl = sl == 2 ? 0 : sl + 1;
            }
#undef MLA_PV
#undef VFRAG
#undef MLA_DMA
            l_run += __shfl_xor(l_run, 32);
            const float inv = __builtin_amdgcn_rcpf(l_run);
            bf16_t* orow = MIX + ((size_t)(bh >> 2) * SEQ + q0 + r32) * DM + 512 + (bh & 3) * 128 + 4 * hf;
#pragma unroll
            for (int mt = 0; mt < 4; ++mt)
#pragma unroll
                for (int a4 = 0; a4 < 4; ++a4) { u32x2 p; p.x = pk2(o[mt][4 * a4] * inv, o[mt][4 * a4 + 1] * inv); p.y = pk2(o[mt][4 * a4 + 2] * inv, o[mt][4 * a4 + 3] * inv);
                    *(u32x2*)(orow + 32 * mt + 8 * a4) = p; }
        }
    }
}

#define RLX_AGENT __ATOMIC_RELAXED, __HIP_MEMORY_SCOPE_AGENT
#define XB_TMO      128
#define XB_XCNT(j)  (256  + 64 * (j))
#define XB_XSUB(j)  (1280 + 64 * (j))
#define XB_XGEN(j)  (2304 + 64 * (j))
#define XB_TOP      3328
#define XB_TOPGEN   3392
#define XCD_BAR_WORDS 3456
#define XB_SPIN_CAP (1u << 18)

__device__ __forceinline__ unsigned xb_ld(unsigned* p)              { return __hip_atomic_load(p, __ATOMIC_RELAXED, __HIP_MEMORY_SCOPE_AGENT); }
__device__ __forceinline__ unsigned xb_add(unsigned* p, unsigned v) { return __hip_atomic_fetch_add(p, v, __ATOMIC_RELAXED, __HIP_MEMORY_SCOPE_AGENT); }
__device__ __forceinline__ unsigned xb_xcc_id() { return (unsigned)__builtin_amdgcn_s_getreg((3 << 11) | 20) & 0xFu; }
#define XB_SPIN(cond, bar) do { unsigned _sp = 0; while (cond) { __builtin_amdgcn_s_sleep(1); \
    if ((++_sp & 255u) == 0u) { if (xb_ld(&(bar)[XB_TMO])) break; if (_sp > XB_SPIN_CAP) { atomicAdd(&(bar)[XB_TMO], 1u); break; } } } } while (0)

struct XcdBarrier {
    unsigned* bar; unsigned x;
    volatile LAS unsigned* st;
};

__device__ __forceinline__ XcdBarrier xcd_barrier_post(unsigned* bar, volatile LAS unsigned* st) {
    XcdBarrier b; b.bar = bar; b.x = xb_xcc_id(); b.st = st;
    if (threadIdx.x == 0) (void)xb_add(&bar[XB_XCNT(b.x)], 1u);
    return b;
}
__device__ __forceinline__ void xcd_barrier_complete(unsigned* bar, unsigned x, unsigned& nloc, unsigned& nx) {
    const unsigned G = gridDim.x * gridDim.y * gridDim.z;
    unsigned sum, cnt, mine, sp = 0u;
    for (;;) {
        sum = 0u; cnt = 0u; mine = 0u;
#pragma unroll
        for (unsigned j = 0; j < 16; ++j) { const unsigned c = xb_ld(&bar[XB_XCNT(j)]); sum += c; cnt += (c > 0u) ? 1u : 0u; mine = (j == x) ? c : mine; }
        if (sum == G) break;
        __builtin_amdgcn_s_sleep(1);
        if ((++sp & 255u) == 0u) { if (xb_ld(&bar[XB_TMO])) break; if (sp > XB_SPIN_CAP) { atomicAdd(&bar[XB_TMO], 1u); break; } }
    }
    nloc = mine > 0u ? mine : 1u; nx = cnt > 0u ? cnt : 1u;
}

__device__ __forceinline__ void xcd_barrier(const XcdBarrier& b) {
    asm volatile("s_waitcnt vmcnt(0)" ::: "memory");
    __syncthreads();
    if (threadIdx.x == 0) {
        unsigned* bar = b.bar;
        __builtin_amdgcn_s_waitcnt(0);
        unsigned nloc = b.st[0], nx = b.st[1];
        if (nloc == 0u) { xcd_barrier_complete(bar, b.x, nloc, nx); b.st[0] = nloc; b.st[1] = nx; }
        const unsigned old = xb_add(&bar[XB_XSUB(b.x)], 1u);
        const unsigned gen = old / nloc;
        if (old + 1u == (gen + 1u) * nloc) {
            __builtin_amdgcn_fence(__ATOMIC_RELEASE, "agent");
            asm volatile("s_waitcnt vmcnt(0)" ::: "memory");
            const unsigned og = xb_add(&bar[XB_TOP], 1u);
            const unsigned tg = og / nx;
            if (og + 1u == (tg + 1u) * nx) xb_add(&bar[XB_TOPGEN], 1u);
            else XB_SPIN(xb_ld(&bar[XB_TOPGEN]) == tg, bar);
            __builtin_amdgcn_fence(__ATOMIC_ACQUIRE, "agent");
            xb_add(&bar[XB_XGEN(b.x)], 1u);
            asm volatile("s_waitcnt vmcnt(0)" ::: "memory");
        } else {
            XB_SPIN(xb_ld(&bar[XB_XGEN(b.x)]) == gen, bar);
            __builtin_amdgcn_fence(__ATOMIC_ACQUIRE, "agent");
            asm volatile("s_waitcnt vmcnt(0)" ::: "memory");
        }
    }
    __syncthreads();
}

__host__ __device__ inline bool phase_empty(int ph) { if (ph == 0) return false; const int L = (ph - 1) / 9, k = (ph - 1) % 9; if (k == 5) return true; if (k == 8) return L != 3; return (L % 2 == 0) && (k == 2 || k == 3); }
constexpr int NPHASE = 37;
#define RUNP(bit, ...) do { if (PHM & (bit)) { __VA_ARGS__; if (REP & (bit)) { __syncthreads(); __VA_ARGS__; } } } while (0)
#ifndef PHM
#define PHM 0xfff
#endif

__global__ void __launch_bounds__(512) mega_fwd(Args a) {
    extern __shared__ __attribute__((aligned(16))) unsigned char lds_raw[];
    LAS unsigned char* lds = (LAS unsigned char*)lds_raw;
    cg::grid_group grid = cg::this_grid();
    unsigned char* ws = a.ws;
    bf16_t* XB = (bf16_t*)(ws + OFF_XB); bf16_t* U = (bf16_t*)(ws + OFF_U); bf16_t* MIX = (bf16_t*)(ws + OFF_MIX); bf16_t* HB = (bf16_t*)(ws + OFF_H);
    bf16_t* Qg = (bf16_t*)(ws + OFF_Q); bf16_t* Kg = (bf16_t*)(ws + OFF_KF); bf16_t* Vtg = (bf16_t*)(ws + OFF_VT);
    float* GST = (float*)(ws + OFF_GST); float* DVEC = (float*)(ws + OFF_DVEC);
    const int G = gridDim.x;
    volatile LAS unsigned* misc = (volatile LAS unsigned*)(lds + LDS_MISC_OFF);
    if (threadIdx.x < 2) misc[threadIdx.x] = 0u;
    __syncthreads();
    XcdBarrier xbar = xcd_barrier_post((unsigned*)(ws + OFF_CTL), misc);
    for (int ph = a.ph_lo; ph < a.ph_hi; ++ph) {
        if (phase_empty(ph)) continue;
        if (ph == 0) { RUNP(1, prologue_phase(a, lds)); }
        else {
            const int L = (ph - 1) / 9, k = (ph - 1) % 9, i = L >> 1; const bool odd = L & 1;
            float* STATS = (float*)(ws + OFF_STATS); const float* C1 = (const float*)(ws + OFF_CV); const float* C2 = C1 + NFOLD;
            if (k == 0) {
                if (ph == 1) fold_reduce(a);
                const bf16_t* Wt = odd ? (const bf16_t*)(ws + OFF_WIN_OD) + (size_t)i * OD_INP * DM : (const bf16_t*)(ws + OFF_WIN_EV) + (size_t)i * EV_IN * DM;
                const int N = odd ? OD_INP : EV_IN;
                pg8::Gemm g{XB, Wt, MTOK, N, DM}; pg8::StaticOrder S; S.init(MTOK, N, G, opq_bid());
                pg8::LnFold f{nullptr, nullptr, nullptr, 0};
                if (L > 0) { f.st = STATS + (size_t)1 * MTOK * 8; f.c1 = C1 + fold_off(L - 1); f.c2 = C2 + fold_off(L - 1); f.on = 1; }
                pg8::EpiBf16 E{U, N, f};
                RUNP(2, pg8::gemm_phase<pg8::EpiBf16, pg8::StaticOrder, true, true>(lds, g, S, E));
            } else if (k == 1) {
                if (!odd) { RUNP(4, conv_phase(U, a.in[2] + (size_t)i * 3 * 512, MIX)); RUNP(8, swa_phase(lds, U, a.in[3] + i * 8, MIX)); }
                else { RUNP(16, mla_prep_phase(lds, U, (const bf16_t*)(ws + OFF_WUQ) + (size_t)i * 384 * 256, (const bf16_t*)(ws + OFF_WUKV) + (size_t)i * 768 * 128, Qg, Kg, Vtg));
                       RUNP(32, gla_local_phase(lds, U, a.in[6] + (size_t)i * 16 * 256, a.in[7] + i * 256, GST, DVEC)); }
            } else if (k == 2) {
                if (PHM & 64) { if (REP & 16384) gla_scan_phase(GST, DVEC, (float*)XB); gla_scan_phase(GST, DVEC, GST); }
                RUNP(128, mla_attn_phase(lds, Qg, Kg, Vtg, MIX));
            } else if (k == 3) {
                RUNP(256, gla_out_phase(lds, U, a.in[6] + (size_t)i * 16 * 256, a.in[7] + i * 256, a.in[8] + i * 128, GST, MIX));
            } else if (k == 4 || k == 7) {
                const bf16_t* A; const bf16_t* Wt; int K; pg8::EpiRes E{nullptr, (L == 3 && k == 7) ? a.out : nullptr, XB, nullptr, nullptr, nullptr, nullptr, DM, ALPHA};
                if (k == 4) { A = MIX; K = DM; Wt = (odd ? (const bf16_t*)(ws + OFF_WOUT_OD) : (const bf16_t*)(ws + OFF_WOUT_EV)) + (size_t)i * DM * DM;
                    if (L == 0) E.xin = a.in[0]; else { E.st_prev = STATS + (size_t)1 * MTOK * 8; E.gp = a.in[19] + (size_t)(L - 1) * DM; E.bp = a.in[20] + (size_t)(L - 1) * DM; }
                    E.st_out = STATS; }
                else { A = HB; K = DFF; Wt = (const bf16_t*)(ws + OFF_WDN) + (size_t)L * DM * DFF;
                    E.st_prev = STATS; E.gp = a.in[17] + (size_t)L * DM; E.bp = a.in[18] + (size_t)L * DM; E.st_out = STATS + (size_t)1 * MTOK * 8; }
                pg8::Gemm g{A, Wt, MTOK, DM, K}; pg8::StaticOrder S; S.init(MTOK, DM, G, opq_bid());
                if (PHM & 512) { pg8::gemm_phase<pg8::EpiRes, pg8::StaticOrder, true, true>(lds, g, S, E);
                    if (REP & 8192) { __syncthreads(); pg8::EpiRes E2 = E; E2.zf = nullptr; E2.zb = U; E2.st_out = (float*)(ws + 480 * MiB); pg8::gemm_phase<pg8::EpiRes, pg8::StaticOrder, true, true>(lds, g, S, E2); } }
            } else if (k == 8) {
                if (PHM & 1024) ln_phase(a.out, a.out, a.in[19] + (size_t)L * DM, a.in[20] + (size_t)L * DM, nullptr);
            } else {
                pg8::Gemm g{XB, (const bf16_t*)(ws + OFF_WGU) + (size_t)L * 2 * DFF * DM, MTOK, 2 * DFF, DM}; pg8::StaticOrder S; S.init(MTOK, 2 * DFF, G, opq_bid());
                pg8::LnFold f{STATS, C1 + fold_off(3 + L), C2 + fold_off(3 + L), 1};
                pg8::EpiSwiglu E{HB, DFF, f};
                RUNP(2048, pg8::gemm_phase<pg8::EpiSwiglu, pg8::StaticOrder, true, true>(lds, g, S, E));
            }
        }
        if (ph + 1 < a.ph_hi) { if (a.ph_lo < 0) grid.sync(); else xcd_barrier(xbar); if (REP & 32768) xcd_barrier(xbar); }
    }
}

extern "C" void kernel_launch(void* const* d_in, const int* in_sizes, int n_in, void* d_out, int out_size, void* d_ws, size_t ws_size, hipStream_t stream) {
    static int grid = 0;
    if (grid == 0) {
        if (n_in != 21 || out_size != MTOK * DM || ws_size < WS_NEED) { fprintf(stderr, "kernel_launch: unexpected shapes (n_in %d out %d ws %zu)\n", n_in, out_size, ws_size); grid = -1; return; }
        int dev = 0, cus = 0, per_cu = 0;
        hipGetDevice(&dev); hipDeviceGetAttribute(&cus, hipDeviceAttributeMultiprocessorCount, dev);
        hipFuncSetAttribute((const void*)mega_fwd, hipFuncAttributeMaxDynamicSharedMemorySize, LDS_BYTES);
        hipOccupancyMaxActiveBlocksPerMultiprocessor(&per_cu, (const void*)mega_fwd, 512, LDS_BYTES);
        if (per_cu < 1) { fprintf(stderr, "kernel_launch: occupancy query gave %d\n", per_cu); per_cu = 1; }
        grid = cus * per_cu;
        (void)hipGetLastError();
    }
    if (grid < 0) return;
    if (hipMemsetAsync((char*)d_ws + OFF_CTL, 0, CTL_BYTES, stream) != hipSuccess) { fprintf(stderr, "kernel_launch: memset failed\n"); return; }
    Args a{};
    for (int i = 0; i < 21; ++i) a.in[i] = (const float*)d_in[i];
    a.out = (float*)d_out; a.ws = (unsigned char*)d_ws;
#if ONE_LAUNCH
    a.ph_lo = 0; a.ph_hi = NPHASE;
    { void* args[] = {&a}; hipError_t e = hipLaunchCooperativeKernel((const void*)mega_fwd, dim3(grid), dim3(512), args, LDS_BYTES, stream);
      if (e != hipSuccess) fprintf(stderr, "cooperative launch failed: %s (grid %d)\n", hipGetErrorString(e), grid); }
#else
    for (int ph = 0; ph < NPHASE; ++ph) {
        if (phase_empty(ph)) continue;
        a.ph_lo = ph; a.ph_hi = ph + 1;
        void* args[] = {&a}; hipError_t e = hipLaunchCooperativeKernel((const void*)mega_fwd, dim3(grid), dim3(512), args, LDS_BYTES, stream);
        if (e != hipSuccess) { fprintf(stderr, "launch of phase %d failed: %s (grid %d)\n", ph, hipGetErrorString(e), grid); break; }
    }
#endif
}
```
